# Optimizing an MI355X kernel written in HIP

```python
import math
import jax, jax.numpy as jnp
from jax import lax
import numpy as np

D_MODEL = 1024
BATCH = 16
SEQ = 256
DEPTH = 4
DEC_BATCH = 8
DEC_SEQ = 1024
PAST_LEN = 256

GRID_W = 64
HEAD_DIM = 64
GROUP_W = D_MODEL // 4
RET_HEADS = GROUP_W // HEAD_DIM
RET_CHUNK = 128
LRU_WIDTH = GROUP_W
LRU_BLOCKS = 4
LRU_BLOCK_W = LRU_WIDTH // LRU_BLOCKS
LRU_CONV_W = 4
LRU_C = 8.0
SWA_HEADS = GROUP_W // HEAD_DIM
SWA_KV_HEADS = 2
SWA_WINDOW = 128
ATTN_BLOCK = 128
DIFF_HEADS = GROUP_W // HEAD_DIM
DIFF_QK_DIM = HEAD_DIM // 2
D_FF = 4 * D_MODEL
ROPE_BASE = 10000.0
EPS = 1e-6
N_MOD = 6
IN_SIZES = (GROUP_W, GROUP_W, GROUP_W, GROUP_W,
            LRU_WIDTH, LRU_WIDTH,
            SWA_HEADS * HEAD_DIM, SWA_KV_HEADS * HEAD_DIM, SWA_KV_HEADS * HEAD_DIM,
            DIFF_HEADS * HEAD_DIM, DIFF_HEADS * HEAD_DIM, DIFF_HEADS * HEAD_DIM)
D_IN = sum(IN_SIZES)

kernel_name = "hybrid_diffusion_parallel_heads_step"

F32 = jnp.float32


def rmsnorm(x, g):
    xf = x.astype(F32)
    y = xf * lax.rsqrt(jnp.mean(xf * xf, -1, keepdims=True) + EPS)
    return (y * g.astype(F32)).astype(x.dtype)


def head_groupnorm(o, g):
    B, L, H, d = o.shape
    of = o.astype(F32)
    mu = jnp.mean(of, -1, keepdims=True)
    var = jnp.mean(jnp.square(of - mu), -1, keepdims=True)
    y = (of - mu) * lax.rsqrt(var + EPS)
    return y.reshape(B, L, H * d) * g.astype(F32)


def head_rmsnorm(o, g):
    of = o.astype(F32)
    y = of * lax.rsqrt(jnp.mean(of * of, -1, keepdims=True) + EPS) * g.astype(F32)
    B, L, H, d = o.shape
    return y.reshape(B, L, H * d)


def modulation(cvec, w, b):
    m = (jax.nn.silu(cvec) @ w + b)[..., None, :]
    return jnp.split(m, N_MOD, axis=-1)


def axial_rope(length, dim):
    rows = length // GRID_W
    row = jnp.repeat(jnp.arange(rows, dtype=F32), GRID_W)
    col = (jnp.arange(length) % GRID_W).astype(F32)
    n = dim // 4
    inv = ROPE_BASE ** (-jnp.arange(n, dtype=F32) / n)
    ang = jnp.concatenate([row[:, None] * inv, col[:, None] * inv], -1)
    return jnp.cos(ang), jnp.sin(ang)


def apply_rope(x, cos, sin):
    x1, x2 = jnp.split(x.astype(F32), 2, -1)
    c = cos[None, :, None, :]
    s = sin[None, :, None, :]
    return jnp.concatenate([x1 * c - x2 * s, x1 * s + x2 * c], -1).astype(x.dtype)


def retention_scan(q, k, v, log_gamma, s0):
    B, L, H, dk = q.shape
    dv = v.shape[-1]
    nc = L // RET_CHUNK
    lg = log_gamma.astype(F32)
    idx = jnp.arange(RET_CHUNK, dtype=F32)
    dist = idx[:, None] - idx[None, :]
    decay_in = jnp.exp(jnp.where((dist >= 0)[None], dist[None] * lg[:, None, None], -jnp.inf))
    xi = jnp.exp((idx[:, None] + 1.0) * lg[None, :])
    zeta = jnp.exp((RET_CHUNK - 1.0 - idx)[:, None] * lg[None, :])
    g_chunk = jnp.exp(RET_CHUNK * lg)

    def to_chunks(t):
        return t.astype(F32).reshape(B, nc, RET_CHUNK, H, t.shape[-1]).swapaxes(0, 1)

    def step(S, inp):
        qc, kc, vc = inp
        scores = jnp.einsum('bnhd,bmhd->bhnm', qc, kc) * decay_in[None]
        o = (jnp.einsum('bhnm,bmhe->bnhe', scores, vc)
             + jnp.einsum('bnhd,bhde->bnhe', qc, S) * xi[None, :, :, None])
        S = S * g_chunk[None, :, None, None] + jnp.einsum('bmhd,bmhe->bhde', kc * zeta[None, :, :, None], vc)
        return S, o

    S, o = lax.scan(step, s0.astype(F32), (to_chunks(q), to_chunks(k), to_chunks(v)))
    return o.swapaxes(0, 1).reshape(B, L, H, dv), S


def retention_mixer(q, k, v, g, decay_logit, gn_g, s0):
    B, L, _ = q.shape
    q = q.reshape(B, L, RET_HEADS, HEAD_DIM)
    k = k.reshape(B, L, RET_HEADS, HEAD_DIM) * (HEAD_DIM ** -0.5)
    v = v.reshape(B, L, RET_HEADS, HEAD_DIM)
    log_gamma = jax.nn.log_sigmoid(decay_logit.astype(F32))
    o_f, s_f = retention_scan(q, k, v, log_gamma[0], s0[:, 0])
    o_b, s_b = retention_scan(q[:, ::-1], k[:, ::-1], v[:, ::-1], log_gamma[1], s0[:, 1])
    y = head_groupnorm(o_f + o_b[:, ::-1], gn_g) * jax.nn.silu(g.astype(F32))
    return y, jnp.stack([s_f, s_b], 1)


def depthwise_conv_centred(x, w, b):
    y = lax.conv_general_dilated(x, w[:, None, :].astype(x.dtype), window_strides=(1,),
                                 padding=[(LRU_CONV_W // 2, LRU_CONV_W - 1 - LRU_CONV_W // 2)],
                                 dimension_numbers=('NWC', 'WIO', 'NWC'), feature_group_count=x.shape[-1])
    return y + b


def linear_scan(a, b, h0):
    def combine(left, right):
        a1, b1 = left
        a2, b2 = right
        return a1 * a2, a2 * b1 + b2
    a_cum, b_cum = lax.associative_scan(combine, (a, b), axis=1)
    return a_cum * h0[:, None, :] + b_cum


def rglru_direction(xc, w_a, b_a, w_x, b_x, lam, h0):
    B, L, C = xc.shape
    xb = xc.reshape(B, L, LRU_BLOCKS, LRU_BLOCK_W)
    r = jax.nn.sigmoid((jnp.einsum('blnc,ncd->blnd', xb, w_a).reshape(B, L, C) + b_a).astype(F32))
    i = jax.nn.sigmoid((jnp.einsum('blnc,ncd->blnd', xb, w_x).reshape(B, L, C) + b_x).astype(F32))
    log_a = -LRU_C * r * jax.nn.softplus(-lam.astype(F32))
    a = jnp.exp(log_a)
    u = jnp.sqrt(-jnp.expm1(2.0 * log_a)) * (i * xc.astype(F32))
    h = linear_scan(a, u, h0.astype(F32))
    return h, h[:, -1]


def rglru_mixer(x_in, gate_in, conv_w, conv_b, w_a, b_a, w_x, b_x, lam, h0):
    xc = depthwise_conv_centred(x_in, conv_w, conv_b)
    h_f, hT_f = rglru_direction(xc, w_a[0], b_a[0], w_x[0], b_x[0], lam[0], h0[:, 0])
    h_b, hT_b = rglru_direction(xc[:, ::-1], w_a[1], b_a[1], w_x[1], b_x[1], lam[1], h0[:, 1])
    y = (h_f + h_b[:, ::-1]) * jax.nn.gelu(gate_in.astype(F32))
    return y, jnp.stack([hT_f, hT_b], 1)


def sink_attention_dense(q, k, v, sink):
    B, Lq, Hq, d = q.shape
    Hkv = k.shape[2]
    G = Hq // Hkv
    nb = Lq // ATTN_BLOCK
    qb = q.reshape(B, nb, ATTN_BLOCK, Hkv, G, d).swapaxes(0, 1)
    sink_l = sink.astype(F32).reshape(Hkv, G)

    def block(qi):
        s = jnp.einsum('bqkgd,bskd->bkgqs', qi, k).astype(F32) * (d ** -0.5)
        s = jnp.concatenate([s, jnp.broadcast_to(sink_l[None, :, :, None, None], s.shape[:-1] + (1,))], -1)
        p = jax.nn.softmax(s, -1)[..., :-1]
        return jnp.einsum('bkgqs,bskd->bqkgd', p.astype(v.dtype), v)

    o = lax.map(block, qb)
    return o.swapaxes(0, 1).reshape(B, Lq, Hq * d)


def window_sink_attention(q, k, v, k_ctx, v_ctx, sink):
    B, L, Hq, d = q.shape
    Hkv = k.shape[2]
    G = Hq // Hkv
    BLK = ATTN_BLOCK
    nb = L // BLK
    qb = q.reshape(B, nb, BLK, Hkv, G, d)

    def band(t):
        tp = jnp.pad(t, ((0, 0), (BLK, BLK), (0, 0), (0, 0))).reshape(B, nb + 2, BLK, Hkv, d)
        return jnp.concatenate([tp[:, :-2], tp[:, 1:-1], tp[:, 2:]], axis=2)

    kw, vw = band(k), band(v)
    qpos = jnp.arange(nb)[:, None] * BLK + jnp.arange(BLK)[None, :]
    kpos = (jnp.arange(nb)[:, None] - 1) * BLK + jnp.arange(3 * BLK)[None, :]
    rel = kpos[:, None, :] - qpos[:, :, None]
    valid = (jnp.abs(rel) <= SWA_WINDOW) & (kpos[:, None, :] >= 0) & (kpos[:, None, :] < L)
    scale = d ** -0.5
    s_loc = jnp.einsum('bnqkgd,bnskd->bnkgqs', qb, kw).astype(F32) * scale
    s_loc = jnp.where(valid[None, :, None, None], s_loc, -jnp.inf)
    s_ctx = jnp.einsum('bnqkgd,bskd->bnkgqs', qb, k_ctx).astype(F32) * scale
    s_sink = jnp.broadcast_to(sink.astype(F32).reshape(1, 1, Hkv, G, 1, 1), s_loc.shape[:-1] + (1,))
    p = jax.nn.softmax(jnp.concatenate([s_loc, s_ctx, s_sink], -1), -1)
    p_loc = p[..., :3 * BLK].astype(v.dtype)
    p_ctx = p[..., 3 * BLK:-1].astype(v.dtype)
    o = (jnp.einsum('bnkgqs,bnskd->bnqkgd', p_loc, vw)
         + jnp.einsum('bnkgqs,bskd->bnqkgd', p_ctx, v_ctx.astype(v.dtype)))
    return o.reshape(B, L, Hq * d)


def diff_attention(q, k, v, lam, norm_g, lambda_init):
    B, Lq, H, _ = q.shape
    Lk = k.shape[1]
    nb = Lq // ATTN_BLOCK
    qb = q.reshape(B, nb, ATTN_BLOCK, H, 2, DIFF_QK_DIM).swapaxes(0, 1)
    kk = k.reshape(B, Lk, H, 2, DIFF_QK_DIM)
    scale = DIFF_QK_DIM ** -0.5

    def block(qi):
        s = jnp.einsum('bqhcd,bshcd->bchqs', qi, kk).astype(F32) * scale
        p = jax.nn.softmax(s, -1)
        w = p[:, 0] - lam * p[:, 1]
        return jnp.einsum('bhqs,bshe->bqhe', w.astype(v.dtype), v)

    o = lax.map(block, qb).swapaxes(0, 1).reshape(B, Lq, H, HEAD_DIM)
    return head_rmsnorm(o, norm_g) * (1.0 - lambda_init)


def trunk_layer(x, cvec, l, p, ctx):
    B, L, _ = x.shape
    sh1, sc1, g1, sh2, sc2, g2 = modulation(cvec, p['w_ada'], p['b_ada'])
    h = rmsnorm(x, p['norm_mix_g']) * (1.0 + sc1) + sh1
    z = h @ p['w_in']
    points, acc = [], 0
    for s in IN_SIZES[:-1]:
        acc += s
        points.append(acc)
    rq, rk, rv, rg, lx, lgate, sq, sk, sv, dq, dk, dv = jnp.split(z, points, axis=-1)
    sq = sq.reshape(B, L, SWA_HEADS, HEAD_DIM)
    sk = sk.reshape(B, L, SWA_KV_HEADS, HEAD_DIM)
    sv = sv.reshape(B, L, SWA_KV_HEADS, HEAD_DIM)
    dq = dq.reshape(B, L, DIFF_HEADS, HEAD_DIM)
    dk = dk.reshape(B, L, DIFF_HEADS, HEAD_DIM)
    dv = dv.reshape(B, L, DIFF_HEADS, HEAD_DIM)

    lambda_init = 0.8 - 0.6 * math.exp(-0.3 * l)
    lv = p['diff_lambda'].astype(F32)
    lam = jnp.exp(jnp.sum(lv[0] * lv[1])) - jnp.exp(jnp.sum(lv[2] * lv[3])) + lambda_init

    if ctx is None:
        s_ret_in = jnp.zeros((B, 2, RET_HEADS, HEAD_DIM, HEAD_DIM), F32)
        s_lru_in = jnp.zeros((B, 2, LRU_WIDTH), F32)
    else:
        s_ret_in, s_lru_in, ck_swa, cv_swa, ck_diff, cv_diff = ctx

    y_ret, s_ret = retention_mixer(rq, rk, rv, rg, p['ret_decay'], p['ret_gn_g'], s_ret_in)
    y_lru, s_lru = rglru_mixer(lx, lgate, p['lru_conv_w'], p['lru_conv_b'], p['lru_w_a'], p['lru_b_a'],
                               p['lru_w_x'], p['lru_b_x'], p['lru_lambda'], s_lru_in)

    if ctx is None:
        y_swa = sink_attention_dense(sq, sk, sv, p['swa_sink'])
        y_diff = diff_attention(dq, dk, dv, lam, p['diff_norm_g'], lambda_init)
        new_ctx = (s_ret, s_lru, sk, sv, dk, dv)
    else:
        cos, sin = axial_rope(L, HEAD_DIM)
        y_swa = window_sink_attention(apply_rope(sq, cos, sin), apply_rope(sk, cos, sin), sv,
                                      ck_swa.astype(sk.dtype), cv_swa, p['swa_sink'])
        cos2, sin2 = axial_rope(L, DIFF_QK_DIM)
        dq_r = apply_rope(dq.reshape(B, L, 2 * DIFF_HEADS, DIFF_QK_DIM), cos2, sin2).reshape(B, L, DIFF_HEADS, HEAD_DIM)
        dk_r = apply_rope(dk.reshape(B, L, 2 * DIFF_HEADS, DIFF_QK_DIM), cos2, sin2).reshape(B, L, DIFF_HEADS, HEAD_DIM)
        k_all = jnp.concatenate([ck_diff.astype(dk_r.dtype), dk_r], axis=1)
        v_all = jnp.concatenate([cv_diff.astype(dv.dtype), dv], axis=1)
        y_diff = diff_attention(dq_r, k_all, v_all, lam, p['diff_norm_g'], lambda_init)
        new_ctx = None

    y = jnp.concatenate([y_ret.astype(x.dtype), y_lru.astype(x.dtype),
                         y_swa.astype(x.dtype), y_diff.astype(x.dtype)], -1) @ p['w_out']
    x = x + g1 * y
    h2 = rmsnorm(x, p['norm_mlp_g']) * (1.0 + sc2) + sh2
    x = x + g2 * (jnp.square(jax.nn.relu(h2 @ p['w_ff1'])) @ p['w_ff2'])
    return x, new_ctx


def setup_inputs(seed: int = 0) -> dict:
    key = jax.random.key(seed)
    ks = jax.random.split(key, 32)
    nrm = lambda k, shape, s=1.0: jax.random.normal(k, shape, F32) * s
    e = 2.0 ** (-5.0 - jnp.arange(RET_HEADS, dtype=F32))
    ret_logit = jnp.log1p(-e) - jnp.log(e)
    u = jax.random.uniform(ks[20], (DEPTH, 2, LRU_WIDTH), F32, minval=0.9, maxval=0.999)
    a0 = u ** (1.0 / LRU_C)
    return {
        "x_prompt": nrm(ks[0], (BATCH, SEQ, D_MODEL)),
        "x_sample": nrm(ks[1], (DEC_BATCH, DEC_SEQ, D_MODEL)),
        "c": nrm(ks[2], (DEC_BATCH, D_MODEL)),
        "state_ret": nrm(ks[3], (DEC_BATCH, DEPTH, 2, RET_HEADS, HEAD_DIM, HEAD_DIM), 0.5),
        "state_lru": nrm(ks[4], (DEC_BATCH, DEPTH, 2, LRU_WIDTH), 0.5),
        "cache_swa_k": nrm(ks[5], (DEC_BATCH, DEPTH, PAST_LEN, SWA_KV_HEADS, HEAD_DIM)),
        "cache_swa_v": nrm(ks[6], (DEC_BATCH, DEPTH, PAST_LEN, SWA_KV_HEADS, HEAD_DIM)),
        "cache_diff_k": nrm(ks[7], (DEC_BATCH, DEPTH, PAST_LEN, DIFF_HEADS, HEAD_DIM)),
        "cache_diff_v": nrm(ks[8], (DEC_BATCH, DEPTH, PAST_LEN, DIFF_HEADS, HEAD_DIM)),
        "c_ctx": nrm(ks[9], (D_MODEL,)),
        "w_ada": nrm(ks[10], (DEPTH, D_MODEL, N_MOD * D_MODEL), 0.5 * D_MODEL ** -0.5),
        "b_ada": nrm(ks[11], (DEPTH, N_MOD * D_MODEL), 0.01),
        "norm_mix_g": 1.0 + nrm(ks[12], (DEPTH, D_MODEL), 0.01),
        "w_in": nrm(ks[13], (DEPTH, D_MODEL, D_IN), D_MODEL ** -0.5),
        "ret_decay": ret_logit + nrm(ks[14], (DEPTH, 2, RET_HEADS), 0.1),
        "ret_gn_g": 1.0 + nrm(ks[15], (DEPTH, GROUP_W), 0.01),
        "lru_conv_w": nrm(ks[16], (DEPTH, LRU_CONV_W, LRU_WIDTH), LRU_CONV_W ** -0.5),
        "lru_conv_b": nrm(ks[17], (DEPTH, LRU_WIDTH), 0.01),
        "lru_w_a": nrm(ks[18], (DEPTH, 2, LRU_BLOCKS, LRU_BLOCK_W, LRU_BLOCK_W), LRU_BLOCK_W ** -0.5),
        "lru_b_a": nrm(ks[19], (DEPTH, 2, LRU_WIDTH), 0.01),
        "lru_w_x": nrm(ks[21], (DEPTH, 2, LRU_BLOCKS, LRU_BLOCK_W, LRU_BLOCK_W), LRU_BLOCK_W ** -0.5),
        "lru_b_x": nrm(ks[22], (DEPTH, 2, LRU_WIDTH), 0.01),
        "lru_lambda": jnp.log(a0) - jnp.log1p(-a0),
        "swa_sink": nrm(ks[23], (DEPTH, SWA_HEADS), 0.5),
        "diff_lambda": nrm(ks[24], (DEPTH, 4, DIFF_QK_DIM), 0.1),
        "diff_norm_g": 1.0 + nrm(ks[25], (DEPTH, HEAD_DIM), 0.01),
        "w_out": nrm(ks[26], (DEPTH, D_MODEL, D_MODEL), D_MODEL ** -0.5),
        "norm_mlp_g": 1.0 + nrm(ks[27], (DEPTH, D_MODEL), 0.01),
        "w_ff1": nrm(ks[28], (DEPTH, D_MODEL, D_FF), D_MODEL ** -0.5),
        "w_ff2": nrm(ks[29], (DEPTH, D_FF, D_MODEL), D_FF ** -0.5),
        "final_norm_g": 1.0 + nrm(ks[30], (D_MODEL,), 0.01),
    }


def reference(x_prompt, x_sample, c, state_ret, state_lru, cache_swa_k, cache_swa_v, cache_diff_k, cache_diff_v,
              c_ctx, w_ada, b_ada, norm_mix_g, w_in, ret_decay, ret_gn_g, lru_conv_w, lru_conv_b,
              lru_w_a, lru_b_a, lru_w_x, lru_b_x, lru_lambda, swa_sink, diff_lambda, diff_norm_g,
              w_out, norm_mlp_g, w_ff1, w_ff2, final_norm_g):
    stacked = dict(w_ada=w_ada, b_ada=b_ada, norm_mix_g=norm_mix_g, w_in=w_in, ret_decay=ret_decay,
                   ret_gn_g=ret_gn_g, lru_conv_w=lru_conv_w, lru_conv_b=lru_conv_b, lru_w_a=lru_w_a,
                   lru_b_a=lru_b_a, lru_w_x=lru_w_x, lru_b_x=lru_b_x, lru_lambda=lru_lambda,
                   swa_sink=swa_sink, diff_lambda=diff_lambda, diff_norm_g=diff_norm_g, w_out=w_out,
                   norm_mlp_g=norm_mlp_g, w_ff1=w_ff1, w_ff2=w_ff2)

    xp = x_prompt
    ctx_list = []
    for l in range(DEPTH):
        p = {name: arr[l] for name, arr in stacked.items()}
        xp, ctx_l = trunk_layer(xp, c_ctx, l, p, None)
        ctx_list.append(ctx_l)
    y_prompt = rmsnorm(xp, final_norm_g)
    new_state_ret = jnp.stack([t[0] for t in ctx_list], axis=1)
    new_state_lru = jnp.stack([t[1] for t in ctx_list], axis=1)
    new_cache_swa_k = jnp.stack([t[2] for t in ctx_list], axis=1)
    new_cache_swa_v = jnp.stack([t[3] for t in ctx_list], axis=1)
    new_cache_diff_k = jnp.stack([t[4] for t in ctx_list], axis=1)
    new_cache_diff_v = jnp.stack([t[5] for t in ctx_list], axis=1)

    xs = x_sample
    for l in range(DEPTH):
        p = {name: arr[l] for name, arr in stacked.items()}
        ctx_l = (state_ret[:, l], state_lru[:, l], cache_swa_k[:, l], cache_swa_v[:, l],
                 cache_diff_k[:, l], cache_diff_v[:, l])
        xs, _ = trunk_layer(xs, c, l, p, ctx_l)
    y_sample = rmsnorm(xs, final_norm_g)

    return (y_prompt, y_sample, new_state_ret, new_state_lru, new_cache_swa_k, new_cache_swa_v,
            new_cache_diff_k, new_cache_diff_v)
```

```cpp
#include <hip/hip_runtime.h>
#include <hip/hip_cooperative_groups.h>
#include <cstdio>
#include <cstdint>
namespace cg = cooperative_groups;
#define TIDX ((int)(wave_s__ * 64 + (int)__builtin_amdgcn_mbcnt_hi(~0u, __builtin_amdgcn_mbcnt_lo(~0u, 0u))))
namespace pg8 {
#define PG8_LAS __attribute__((address_space(3)))
typedef unsigned short bf16_t;
typedef short bf16x8 __attribute__((ext_vector_type(8)));
typedef float f32x4 __attribute__((ext_vector_type(4)));
typedef unsigned u32x4 __attribute__((ext_vector_type(4)));
constexpr int BM = 256, BK = 64, HALF = 128, HTB = HALF * BK * 2  , STAGE_BYTES = 8 * HTB, NXCD = 8, WGM = 8;

__host__ __device__ __forceinline__ int lds_byte(int r, int c) { const int st = (r >> 4) * 2 + (c >> 5), rr = r & 15, cc = c & 31, ob = rr * 64 + cc * 2; return st * 1024 + (ob ^ (((ob >> 9) & 1) << 5)); }
__host__ __device__ __forceinline__ void stage_rc(int b, int& R, int& C) { const int st = b / 1024, sb = b % 1024, swz = sb ^ (((sb >> 9) & 1) << 5); R = (st >> 1) * 16 + swz / 64; C = (st & 1) * 32 + (swz % 64) / 2; }
__host__ __device__ __forceinline__ int perm32(int rho) { const int n = rho >> 4, i = rho & 15; return 8 * (i >> 2) + 4 * n + (i & 3); }

struct Unit { int pm, pn; };
struct Gemm { const bf16_t* A; const bf16_t* Bt; int M, N, K; };

struct StaticOrder {
    int nM, nN, nwg, G, c;
    __host__ __device__ void init(int M, int N, int G_, int c_) { nM = M / BM; nN = N / BM; nwg = nM * nN; G = G_; c = c_; }
    __host__ __device__ bool next(int i, Unit& u) const {
        const long L = (long)i * G + c; if (L >= nwg) return false;
        int wgid = (int)L; { const int q = nwg / NXCD, r = nwg % NXCD, xcd = wgid % NXCD, off = wgid / NXCD; wgid = (xcd < r ? xcd * (q + 1) : r * (q + 1) + (xcd - r) * q) + off; }
        const int nig = WGM * nN, gid = wgid / nig, fm = gid * WGM, gsz = (nM - fm) < WGM ? (nM - fm) : WGM;
        u.pm = fm + ((wgid % nig) % gsz); u.pn = (wgid % nig) / gsz; return true;
    }
    __device__ __forceinline__ void a_ready(const Unit&) const {}
    __device__ __forceinline__ void done(const Unit&) const {}
};
__device__ __forceinline__ unsigned cvt_pk_bf16(float lo, float hi) { unsigned r; asm volatile("v_cvt_pk_bf16_f32 %0, %1, %2" : "=v"(r) : "v"(lo), "v"(hi)); return r; }

template <class Epi, class Sched, bool ALIGN_EPI = false, bool SP2 = false>
__device__ __forceinline__ void gemm_phase(PG8_LAS unsigned char* lds, const Gemm g, const Sched& S, const Epi& E, const int wave_s__) {
    int tid_l = TIDX; asm volatile("" : "+v"(tid_l));
    const int tid = tid_l, wid = __builtin_amdgcn_readfirstlane(tid >> 6), lane = tid & 63, wr = wid >> 2, wc = wid & 3, fr = lane & 15, fq = lane >> 4;
    const int K = g.K, nt = K / BK;
    unsigned voffA[2], voffB[2];
#pragma unroll
    for (int i = 0; i < 2; ++i) { int R, C; stage_rc(tid * 16 + i * 8192, R, C); const int Rb = Epi::PERM ? ((R & ~31) + perm32(R & 31)) : R;
        voffA[i] = (unsigned)(R * K + C) * 2u; voffB[i] = (unsigned)(Rb * K + C) * 2u; }
    const size_t kstep = (size_t)(BK * 2);
    const size_t hstep = (size_t)HALF * K * 2;
    const size_t tstep = 2 * hstep;
    const unsigned ldsw = (unsigned)wid * 1024u;
    const int aoff = lds_byte(wr * 64 + fr, fq * 8), boff = lds_byte(wc * 32 + fr, fq * 8);
#define PG8_SA(b, h) (((b) * 2 + (h)) * HTB)
#define PG8_SB(b, h) ((4 + (b) * 2 + (h)) * HTB)
#define PG8_STAGE(bufoff, gbase, voff) do { _Pragma("unroll") for (int _i = 0; _i < 2; ++_i) \
        __builtin_amdgcn_global_load_lds((const unsigned*)((const char*)(gbase) + (voff)[_i]), (PG8_LAS unsigned*)(lds + (bufoff) + ldsw + _i * 8192), 16, 0, 0); } while (0)
#define PG8_LDA(dst, b, h) do { _Pragma("unroll") for (int m = 0; m < 4; ++m) _Pragma("unroll") for (int k = 0; k < 2; ++k) dst[m][k] = *(const PG8_LAS bf16x8*)(lds + PG8_SA(b, h) + aoff + m * 2048 + k * 1024); } while (0)
#define PG8_LDB(dst, b, h) do { _Pragma("unroll") for (int n = 0; n < 2; ++n) _Pragma("unroll") for (int k = 0; k < 2; ++k) dst[n][k] = *(const PG8_LAS bf16x8*)(lds + PG8_SB(b, h) + boff + n * 2048 + k * 1024); } while (0)
#define PG8_MMA(ai, bj, At, Bt) do { __builtin_amdgcn_s_setprio(1); _Pragma("unroll") for (int m = 0; m < 4; ++m) _Pragma("unroll") for (int n = 0; n < 2; ++n) _Pragma("unroll") for (int k = 0; k < 2; ++k) \
        acc[ai][bj][m][n] = __builtin_amdgcn_mfma_f32_16x16x32_bf16(Bt[n][k], At[m][k], acc[ai][bj][m][n], 0, 0, 0); __builtin_amdgcn_s_setprio(0); } while (0)
#define PG8_WAIT_V(n) asm volatile("s_waitcnt vmcnt(" #n ")" ::: "memory")
#define PG8_WAIT_L(n) asm volatile("s_waitcnt lgkmcnt(" #n ")" ::: "memory")
#define PG8_BAR __builtin_amdgcn_s_barrier()
#define PG8_SCHED __builtin_amdgcn_sched_barrier(0)
    Unit cur, nxt; int ui = 0;
    if (!S.next(0, cur)) return;
    f32x4 acc[2][2][4][2];
#pragma unroll
    for (int a = 0; a < 2; ++a)
#pragma unroll
        for (int b = 0; b < 2; ++b)
#pragma unroll
            for (int m = 0; m < 4; ++m)
#pragma unroll
                for (int n = 0; n < 2; ++n) acc[a][b][m][n] = (f32x4){0.f, 0.f, 0.f, 0.f};
    bf16x8 At[4][2], B0[2][2], B1[2][2];
    const char* cA = (const char*)g.A + (size_t)cur.pm * tstep; const char* cB = (const char*)g.Bt + (size_t)cur.pn * tstep;
    S.a_ready(cur);
    if constexpr (SP2) {
        PG8_STAGE(PG8_SB(0, 0), cB, voffB); PG8_STAGE(PG8_SB(0, 1), cB + hstep, voffB); PG8_STAGE(PG8_SA(0, 0), cA, voffA); PG8_STAGE(PG8_SA(0, 1), cA + hstep, voffA);
        if (wr == 1) PG8_BAR;
        PG8_WAIT_V(2); PG8_BAR;
        PG8_STAGE(PG8_SB(1, 0), cB + kstep, voffB); PG8_STAGE(PG8_SA(1, 0), cA + kstep, voffA); PG8_STAGE(PG8_SB(1, 1), cB + hstep + kstep, voffB);
        PG8_WAIT_V(6); PG8_BAR;
    } else {
        PG8_STAGE(PG8_SB(0, 0), cB, voffB); PG8_STAGE(PG8_SA(0, 0), cA, voffA); PG8_STAGE(PG8_SB(0, 1), cB + hstep, voffB); PG8_STAGE(PG8_SA(0, 1), cA + hstep, voffA);
        if (wr == 1) PG8_BAR;
        PG8_WAIT_V(4); PG8_BAR;
        PG8_STAGE(PG8_SB(1, 0), cB + kstep, voffB); PG8_STAGE(PG8_SA(1, 0), cA + kstep, voffA); PG8_STAGE(PG8_SB(1, 1), cB + hstep + kstep, voffB);
        PG8_WAIT_V(6); PG8_BAR;
    }
    for (;;) {
        const bool has_next = S.next(ui + 1, nxt);
        const char* nA = has_next ? (const char*)g.A + (size_t)nxt.pm * tstep : cA; const char* nB = has_next ? (const char*)g.Bt + (size_t)nxt.pn * tstep : cB;
        for (int t = 0; t < nt; t += 2) {
            const bool last = (t == nt - 2);
            const char* a1 = cA + (size_t)(t + 1) * kstep;
            const char* a2 = last ? nA : cA + (size_t)(t + 2) * kstep; const char* b2 = last ? nB : cB + (size_t)(t + 2) * kstep;
            const char* a3 = a2 + kstep; const char* b3 = b2 + kstep;
            if (last && has_next) S.a_ready(nxt);
            if constexpr (SP2) {
            PG8_LDB(B0, 0, 0); PG8_LDB(B1, 0, 1); PG8_SCHED; PG8_LDA(At, 0, 0); PG8_STAGE(PG8_SA(1, 1), a1 + hstep, voffA);
            PG8_WAIT_V(8); PG8_WAIT_L(0); PG8_BAR; PG8_MMA(0, 0, At, B0); PG8_MMA(0, 1, At, B1); PG8_BAR; PG8_SCHED;
            PG8_LDA(At, 0, 1); PG8_STAGE(PG8_SB(0, 0), b2, voffB); PG8_STAGE(PG8_SB(0, 1), b2 + hstep, voffB); PG8_STAGE(PG8_SA(0, 0), a2, voffA);
            PG8_WAIT_V(8); PG8_WAIT_L(0); PG8_BAR; PG8_MMA(1, 0, At, B0); PG8_MMA(1, 1, At, B1); PG8_BAR; PG8_SCHED;
            PG8_LDB(B0, 1, 0); PG8_LDB(B1, 1, 1); PG8_SCHED; PG8_LDA(At, 1, 0); PG8_STAGE(PG8_SA(0, 1), a2 + hstep, voffA);
            PG8_WAIT_V(8); PG8_WAIT_L(0); PG8_BAR; PG8_MMA(0, 0, At, B0); PG8_MMA(0, 1, At, B1); PG8_BAR; PG8_SCHED;
            PG8_LDA(At, 1, 1); PG8_STAGE(PG8_SB(1, 0), b3, voffB); PG8_STAGE(PG8_SB(1, 1), b3 + hstep, voffB); PG8_STAGE(PG8_SA(1, 0), a3, voffA);
            PG8_WAIT_V(8); PG8_WAIT_L(0); PG8_BAR; PG8_MMA(1, 0, At, B0); PG8_MMA(1, 1, At, B1); PG8_BAR; PG8_SCHED;
            } else {
            PG8_LDB(B0, 0, 0); PG8_SCHED; PG8_LDA(At, 0, 0); PG8_STAGE(PG8_SA(1, 1), a1 + hstep, voffA);
            PG8_WAIT_L(8); PG8_BAR; PG8_WAIT_L(0); PG8_MMA(0, 0, At, B0); PG8_BAR; PG8_SCHED;
            PG8_LDB(B1, 0, 1); PG8_STAGE(PG8_SB(0, 0), b2, voffB);
            PG8_BAR; PG8_WAIT_L(0); PG8_MMA(0, 1, At, B1); PG8_BAR;
            PG8_LDA(At, 0, 1); PG8_STAGE(PG8_SA(0, 0), a2, voffA);
            PG8_BAR; PG8_WAIT_L(0); PG8_MMA(1, 0, At, B0); PG8_BAR; PG8_SCHED;
            PG8_STAGE(PG8_SB(0, 1), b2 + hstep, voffB);
            PG8_WAIT_V(6); PG8_BAR; PG8_MMA(1, 1, At, B1); PG8_BAR;
            PG8_LDB(B0, 1, 0); PG8_SCHED; PG8_LDA(At, 1, 0); PG8_STAGE(PG8_SA(0, 1), a2 + hstep, voffA);
            PG8_WAIT_L(8); PG8_BAR; PG8_WAIT_L(0); PG8_MMA(0, 0, At, B0); PG8_BAR; PG8_SCHED;
            PG8_LDB(B1, 1, 1); PG8_STAGE(PG8_SB(1, 0), b3, voffB);
            PG8_BAR; PG8_WAIT_L(0); PG8_MMA(0, 1, At, B1); PG8_BAR;
            PG8_LDA(At, 1, 1); PG8_STAGE(PG8_SA(1, 0), a3, voffA);
            PG8_BAR; PG8_WAIT_L(0); PG8_MMA(1, 0, At, B0); PG8_BAR; PG8_SCHED;
            PG8_STAGE(PG8_SB(1, 1), b3 + hstep, voffB);
            PG8_WAIT_V(6); PG8_BAR; PG8_MMA(1, 1, At, B1); PG8_BAR;
            }
        }
        if constexpr (ALIGN_EPI) { if (wr == 0) PG8_BAR; }
        if constexpr (!Epi::AFTER_DRAIN) { E(acc, cur, wr, wc, fr, fq); S.done(cur); }
        if (!has_next) break;
#pragma unroll
        for (int a = 0; a < 2; ++a)
#pragma unroll
            for (int b = 0; b < 2; ++b)
#pragma unroll
                for (int m = 0; m < 4; ++m)
#pragma unroll
                    for (int n = 0; n < 2; ++n) acc[a][b][m][n] = (f32x4){0.f, 0.f, 0.f, 0.f};
        cur = nxt; cA = nA; cB = nB; ++ui;
        if constexpr (ALIGN_EPI) { if (wr == 1) PG8_BAR; }
    }
    PG8_WAIT_V(0);
    if constexpr (!ALIGN_EPI) { if (wr == 0) PG8_BAR; }
    PG8_BAR;
    if constexpr (Epi::AFTER_DRAIN) { E.fused(acc, cur, wr, wc, fr, fq, lds, wid, lane); S.done(cur); }
#undef PG8_SA
#undef PG8_SB
#undef PG8_STAGE
#undef PG8_LDA
#undef PG8_LDB
#undef PG8_MMA
#undef PG8_WAIT_V
#undef PG8_WAIT_L
#undef PG8_BAR
#undef PG8_SCHED
}
}

#define LAS __attribute__((address_space(3)))
typedef unsigned short bf16;
typedef short bf16x8 __attribute__((ext_vector_type(8)));
typedef float f32x4 __attribute__((ext_vector_type(4)));
typedef unsigned u32x4 __attribute__((ext_vector_type(4)));
typedef unsigned u32x2 __attribute__((ext_vector_type(2)));
typedef float f32x2 __attribute__((ext_vector_type(2)));

constexpr int DM = 1024, DIN = 2816, DFF = 4096, NTOK = 12288, NCTX = 4096, NG = 9, NMOD = 6144;
constexpr float EPS = 1e-6f, LOG2E = 1.4426950408889634f;
constexpr int NT = 512;
enum { I_XP = 0, I_XS, I_C, I_SRET, I_SLRU, I_CSK, I_CSV, I_CDK, I_CDV, I_CCTX, I_WADA, I_BADA, I_NMIXG, I_WIN, I_RDEC, I_RGN, I_LCW, I_LCB,
       I_LWA, I_LBA, I_LWX, I_LBX, I_LLAM, I_SINK, I_DLAM, I_DNG, I_WOUT, I_NMLPG, I_WFF1, I_WFF2, I_FNG, N_IN };
constexpr size_t O_YP = 0, O_YS = 4194304, O_SRET = 12582912, O_SLRU = 14680064, O_SWAK = 14712832, O_SWAV = 16809984, O_DK = 18907136, O_DV = 23101440;
constexpr size_t MiB = 1u << 20;
constexpr size_t WS_CTL = 0, WS_MOD = 1 * MiB, WS_GM = 2 * MiB, WS_B1 = 3 * MiB, WS_B2 = 4 * MiB, WS_CS64 = 5 * MiB, WS_CS32 = 5 * MiB + 512 * 1024, WS_SS = 6 * MiB,
                 WS_WIN = 8 * MiB, WS_WOUT = 30 * MiB, WS_WFF1 = 38 * MiB, WS_WFF2 = 70 * MiB, WS_X = 102 * MiB, WS_XB = 150 * MiB, WS_Z = 174 * MiB, WS_Y = 240 * MiB,
                 WS_H = 264 * MiB, WS_END = 360 * MiB;
constexpr size_t WS_WLRU = 7 * MiB;
constexpr size_t WS_HS = WS_H, WS_PF = WS_H + 16 * MiB, WS_PB = WS_H + 32 * MiB, WS_TOT = WS_H + 48 * MiB;
constexpr int CW_LRU = 1024;
constexpr int LDS_BYTES = 139264;
constexpr int LDS_MISC = 131072;
constexpr int CW_BAR = 4096;

struct Args { const float* in[N_IN]; float* out; unsigned char* ws; };

__device__ __forceinline__ unsigned f2bf(float f) { unsigned u = __builtin_bit_cast(unsigned, f); return (u + 0x7fffu + ((u >> 16) & 1u)) >> 16; }
typedef float f32x2_t __attribute__((ext_vector_type(2))); typedef __bf16 bf16x2_t __attribute__((ext_vector_type(2)));
__device__ __forceinline__ unsigned pk2(float lo, float hi) { const f32x2_t v = {lo, hi}; const bf16x2_t b = __builtin_convertvector(v, bf16x2_t); return __builtin_bit_cast(unsigned, b); }
__host__ __device__ __forceinline__ int perm_in(int c) {
    if (c >= 1536 && c < 1920) { const int i = c & 63; return (c & ~63) + (i < 32 ? 2 * i : 2 * (i - 32) + 1); }
    if (c >= 2048 && c < 2560) { const int i = c & 31; return (c & ~31) + (i < 16 ? 2 * i : 2 * (i - 16) + 1); }
    return c;
}
__device__ __forceinline__ float bflo(unsigned w) { return __builtin_bit_cast(float, w << 16); }
__device__ __forceinline__ float bfhi(unsigned w) { return __builtin_bit_cast(float, w & 0xffff0000u); }
__device__ __forceinline__ float bf2f(bf16 v) { return __builtin_bit_cast(float, (unsigned)v << 16); }
__device__ __forceinline__ void unpack8(const u32x4 r, float (&f)[8]) { f[0] = bflo(r.x); f[1] = bfhi(r.x); f[2] = bflo(r.y); f[3] = bfhi(r.y); f[4] = bflo(r.z); f[5] = bfhi(r.z); f[6] = bflo(r.w); f[7] = bfhi(r.w); }
__device__ __forceinline__ u32x4 pack8(const float (&f)[8]) { u32x4 r; r.x = pk2(f[0], f[1]); r.y = pk2(f[2], f[3]); r.z = pk2(f[4], f[5]); r.w = pk2(f[6], f[7]); return r; }
__device__ __forceinline__ float ex2(float x) { return __builtin_amdgcn_exp2f(x); }
__device__ __forceinline__ float asf_(unsigned u) { return __builtin_bit_cast(float, u); }
__device__ __forceinline__ unsigned asu_(float f) { return __builtin_bit_cast(unsigned, f); }
__device__ __forceinline__ float sum_x16(float v) { const auto r = __builtin_amdgcn_permlane16_swap(asu_(v), asu_(v), false, false); return asf_(r[0]) + asf_(r[1]); }
__device__ __forceinline__ float sum_x32(float v) { const auto r = __builtin_amdgcn_permlane32_swap(asu_(v), asu_(v), false, false); return asf_(r[0]) + asf_(r[1]); }
__device__ __forceinline__ float max_x16(float v) { const auto r = __builtin_amdgcn_permlane16_swap(asu_(v), asu_(v), false, false); return fmaxf(asf_(r[0]), asf_(r[1])); }
__device__ __forceinline__ float max_x32(float v) { const auto r = __builtin_amdgcn_permlane32_swap(asu_(v), asu_(v), false, false); return fmaxf(asf_(r[0]), asf_(r[1])); }
__device__ __forceinline__ float wave_sum(float v) {
    v += asf_(__builtin_amdgcn_update_dpp(0, asu_(v), 0xB1, 0xF, 0xF, true));
    v += asf_(__builtin_amdgcn_update_dpp(0, asu_(v), 0x4E, 0xF, 0xF, true));
    v += asf_(__builtin_amdgcn_update_dpp(0, asu_(v), 0x141, 0xF, 0xF, true));
    v += asf_(__builtin_amdgcn_update_dpp(0, asu_(v), 0x140, 0xF, 0xF, true));
    v = sum_x16(v); return sum_x32(v);
}
__device__ __forceinline__ float rcp_(float x) { return __builtin_amdgcn_rcpf(x); }
__device__ __forceinline__ float sigmoidf_(float x) { return rcp_(1.f + __expf(-x)); }
__device__ __forceinline__ int grp_of_tile(int pm) { return pm < 16 ? 0 : 1 + ((pm - 16) >> 2); }
__device__ __forceinline__ int grp_of_row(int row) { return row < NCTX ? 0 : 1 + ((row - NCTX) >> 10); }
__device__ __forceinline__ float rstd_of(const float* SS, int row) {
    const f32x4* sp = (const f32x4*)(SS + (size_t)row * 16); const f32x4 a = sp[0], b = sp[1], c = sp[2], d = sp[3];
    const float s = ((a.x + a.y) + (a.z + a.w)) + ((b.x + b.y) + (b.z + b.w)) + ((c.x + c.y) + (c.z + c.w)) + ((d.x + d.y) + (d.z + d.w));
    return rsqrtf(s * (1.f / DM) + EPS);
}
__device__ __forceinline__ float rstd_of4(const float* SS, int row, int fq) {
    const f32x4 a = *(const f32x4*)(SS + (size_t)row * 16 + 4 * fq);
    float s = (a.x + a.y) + (a.z + a.w); s = sum_x16(s); s = sum_x32(s);
    return rsqrtf(s * (1.f / DM) + EPS);
}
#define GAS __attribute__((address_space(1)))
__device__ __forceinline__ void st_wt(float* p, float v) { __hip_atomic_store((GAS float*)p, v, __ATOMIC_RELAXED, __HIP_MEMORY_SCOPE_AGENT); }
__device__ __forceinline__ float ld_wt(const float* p) { return __hip_atomic_load((GAS float*)p, __ATOMIC_RELAXED, __HIP_MEMORY_SCOPE_AGENT); }
struct EpiIn {
    static constexpr bool PERM = true, AFTER_DRAIN = false;
    bf16* Z; const float* SS; const float* bias; float* out; const f32x4* cs64; const f32x4* cs32; int layer;
    __device__ __forceinline__ void operator()(const f32x4 (&acc)[2][2][4][2], const pg8::Unit& u, int wr, int wc, int fr_, int fq_) const {
        int fr = fr_, fq = fq_; asm volatile("" : "+v"(fr), "+v"(fq));
        const int g = grp_of_tile(u.pm), row0 = u.pm * 256 + wr * 64 + fr, ct0 = wc * 32 + 8 * fq, col0 = u.pn * 256 + ct0;
        const float* bp = bias + g * DIN + col0;
        f32x4 bv[2][2];
#pragma unroll
        for (int bj = 0; bj < 2; ++bj)
#pragma unroll
            for (int n = 0; n < 2; ++n) bv[bj][n] = *(const f32x4*)(bp + bj * 128 + 4 * n);
        const bool cache = (u.pm < 16) && (u.pn == 7 || u.pn == 9 || u.pn == 10);
        int rk[2] = {0, 0};
        if (u.pm >= 16) { if (u.pn == 6) { rk[0] = 64; rk[1] = 64; } else if (u.pn == 7) { rk[0] = 64; } else if (u.pn == 8 || u.pn == 9) { rk[0] = 32; rk[1] = 32; } }
#pragma unroll
        for (int ai = 0; ai < 2; ++ai)
#pragma unroll
            for (int m = 0; m < 4; ++m) {
                const int row = row0 + ai * 128 + m * 16; const float rs = rstd_of4(SS, row, fq);
#pragma unroll
                for (int bj = 0; bj < 2; ++bj) {
                    f32x4 v0 = acc[ai][bj][m][0] * rs + bv[bj][0], v1 = acc[ai][bj][m][1] * rs + bv[bj][1];
                    const int ct = ct0 + bj * 128;
                    if (rk[bj]) {
                        const int t = (row - NCTX) & 1023; f32x4 c01, c23;
                        if (rk[bj] == 64) { const float* tf = (const float*)cs64 + (size_t)t * 64 + (ct & 63); c01 = *(const f32x4*)tf; c23 = *(const f32x4*)(tf + 4); }
                        else { const float* tf = (const float*)cs32 + (size_t)t * 32 + (ct & 31); c01 = *(const f32x4*)tf; c23 = *(const f32x4*)(tf + 4); }
                        const float a0 = v0[0], b0 = v0[1], a1 = v0[2], b1 = v0[3], a2 = v1[0], b2 = v1[1], a3 = v1[2], b3 = v1[3];
                        v0[0] = a0 * c01[0] - b0 * c01[1]; v0[1] = a0 * c01[1] + b0 * c01[0]; v0[2] = a1 * c01[2] - b1 * c01[3]; v0[3] = a1 * c01[3] + b1 * c01[2];
                        v1[0] = a2 * c23[0] - b2 * c23[1]; v1[1] = a2 * c23[1] + b2 * c23[0]; v1[2] = a3 * c23[2] - b3 * c23[3]; v1[3] = a3 * c23[3] + b3 * c23[2];
                    }
                    u32x4 w; w.x = pk2(v0[0], v0[1]); w.y = pk2(v0[2], v0[3]); w.z = pk2(v1[0], v1[1]); w.w = pk2(v1[2], v1[3]);
                    *(u32x4*)(Z + (size_t)row * DIN + col0 + bj * 128) = w;
                    if (cache) {
                        const int b = u.pm, t = row - b * 256;
                        if (u.pn == 7 && bj == 0) {
                            float* dst = out + O_SWAK + ((size_t)(b * 4 + layer) * 256 + t) * 128 + (ct & ~63) + ((ct & 63) >> 1);
                            __builtin_nontemporal_store((f32x4){v0[0], v0[2], v1[0], v1[2]}, (f32x4*)dst); __builtin_nontemporal_store((f32x4){v0[1], v0[3], v1[1], v1[3]}, (f32x4*)(dst + 32));
                        } else if (u.pn == 9) {
                            float* dst = out + O_DK + ((size_t)(b * 4 + layer) * 256 + t) * 256 + (ct & ~31) + ((ct & 31) >> 1);
                            __builtin_nontemporal_store((f32x4){v0[0], v0[2], v1[0], v1[2]}, (f32x4*)dst); __builtin_nontemporal_store((f32x4){v0[1], v0[3], v1[1], v1[3]}, (f32x4*)(dst + 16));
                        } else {
                            float* dst = u.pn == 7 ? out + O_SWAV + ((size_t)(b * 4 + layer) * 256 + t) * 128 + ct - 128 : out + O_DV + ((size_t)(b * 4 + layer) * 256 + t) * 256 + ct;
                            __builtin_nontemporal_store(v0, (f32x4*)dst); __builtin_nontemporal_store(v1, (f32x4*)(dst + 4));
                        }
                    }
                }
            }
    }
};
struct EpiRes {
    static constexpr bool PERM = true, AFTER_DRAIN = false;
    bf16* X; bf16* XB; float* SS; const float* gate; const float* gm;
    __device__ __forceinline__ void operator()(const f32x4 (&acc)[2][2][4][2], const pg8::Unit& u, int wr, int wc, int fr_, int fq_) const {
        int fr = fr_, fq = fq_; asm volatile("" : "+v"(fr), "+v"(fq));
        const int g = grp_of_tile(u.pm), row0 = u.pm * 256 + wr * 64 + fr, col0 = u.pn * 256 + wc * 32 + 8 * fq;
        f32x4 gv[2][2], mv[2][2];
#pragma unroll
        for (int bj = 0; bj < 2; ++bj)
#pragma unroll
            for (int n = 0; n < 2; ++n) { gv[bj][n] = *(const f32x4*)(gate + (size_t)g * NMOD + col0 + bj * 128 + 4 * n);
                mv[bj][n] = gm ? *(const f32x4*)(gm + (size_t)g * DM + col0 + bj * 128 + 4 * n) : (f32x4){0.f, 0.f, 0.f, 0.f}; }
#pragma unroll
        for (int ai = 0; ai < 2; ++ai) {
            u32x4 xr[4][2];
#pragma unroll
            for (int m = 0; m < 4; ++m)
#pragma unroll
                for (int bj = 0; bj < 2; ++bj) xr[m][bj] = *(const u32x4*)(X + (size_t)(row0 + ai * 128 + m * 16) * DM + col0 + bj * 128);
#pragma unroll
            for (int m = 0; m < 4; ++m) {
                const int row = row0 + ai * 128 + m * 16; float ss = 0.f;
#pragma unroll
                for (int bj = 0; bj < 2; ++bj) {
                    float xf[8]; unpack8(xr[m][bj], xf);
                    const f32x4 x0 = (f32x4){xf[0], xf[1], xf[2], xf[3]} + gv[bj][0] * acc[ai][bj][m][0], x1 = (f32x4){xf[4], xf[5], xf[6], xf[7]} + gv[bj][1] * acc[ai][bj][m][1];
                    u32x4 wx; wx.x = pk2(x0[0], x0[1]); wx.y = pk2(x0[2], x0[3]); wx.z = pk2(x1[0], x1[1]); wx.w = pk2(x1[2], x1[3]);
                    *(u32x4*)(X + (size_t)row * DM + col0 + bj * 128) = wx;
                    ss += (x0[0] * x0[0] + x0[1] * x0[1]) + (x0[2] * x0[2] + x0[3] * x0[3]) + (x1[0] * x1[0] + x1[1] * x1[1]) + (x1[2] * x1[2] + x1[3] * x1[3]);
                    if (gm) { const f32x4 y0 = x0 * mv[bj][0], y1 = x1 * mv[bj][1];
                        u32x4 w; w.x = pk2(y0[0], y0[1]); w.y = pk2(y0[2], y0[3]); w.z = pk2(y1[0], y1[1]); w.w = pk2(y1[2], y1[3]);
                        *(u32x4*)(XB + (size_t)row * DM + col0 + bj * 128) = w; }
                }
                ss = sum_x16(ss); ss = sum_x32(ss);
                if (fq == 0) SS[(size_t)row * 16 + u.pn * 4 + wc] = ss;
            }
        }
    }
};
struct EpiFF1 {
    static constexpr bool PERM = true, AFTER_DRAIN = false;
    bf16* H; const float* SS; const float* bias;
    __device__ __forceinline__ void operator()(const f32x4 (&acc)[2][2][4][2], const pg8::Unit& u, int wr, int wc, int fr_, int fq_) const {
        int fr = fr_, fq = fq_; asm volatile("" : "+v"(fr), "+v"(fq));
        const int g = grp_of_tile(u.pm), row0 = u.pm * 256 + wr * 64 + fr, col0 = u.pn * 256 + wc * 32 + 8 * fq;
        const float* bp = bias + g * DFF + col0;
        f32x4 bv[2][2];
#pragma unroll
        for (int bj = 0; bj < 2; ++bj)
#pragma unroll
            for (int n = 0; n < 2; ++n) bv[bj][n] = *(const f32x4*)(bp + bj * 128 + 4 * n);
#pragma unroll
        for (int ai = 0; ai < 2; ++ai)
#pragma unroll
            for (int m = 0; m < 4; ++m) {
                const int row = row0 + ai * 128 + m * 16; const float rs = rstd_of4(SS, row, fq);
#pragma unroll
                for (int bj = 0; bj < 2; ++bj) {
                    f32x4 v0 = acc[ai][bj][m][0] * rs + bv[bj][0], v1 = acc[ai][bj][m][1] * rs + bv[bj][1];
#pragma unroll
                    for (int e = 0; e < 4; ++e) { const float a = fmaxf(v0[e], 0.f), b = fmaxf(v1[e], 0.f); v0[e] = a * a; v1[e] = b * b; }
                    u32x4 w; w.x = pk2(v0[0], v0[1]); w.y = pk2(v0[2], v0[3]); w.z = pk2(v1[0], v1[1]); w.w = pk2(v1[2], v1[3]);
                    *(u32x4*)(H + (size_t)row * DFF + col0 + bj * 128) = w;
                }
            }
    }
};

struct InOrder {
    int G, c;
    __host__ __device__ static void decode(int w, int nM, int nN, int& pm, int& pn) {
        const int nwg = nM * nN, q = nwg / 8, r = nwg % 8, xcd = w % 8, off = w / 8; const int wg = (xcd < r ? xcd * (q + 1) : r * (q + 1) + (xcd - r) * q) + off;
        const int nig = 8 * nN, gid = wg / nig, fm = gid * 8, gsz = (nM - fm) < 8 ? (nM - fm) : 8; pm = fm + ((wg % nig) % gsz); pn = (wg % nig) / gsz;
    }
    __host__ __device__ bool next(int i, pg8::Unit& u) const {
        const long L = (long)i * G + c; if (L >= 512) return false;
        int pm, pn;
        if (L < 352) { decode((int)L, 32, 11, pm, pn); u.pm = 16 + pm; u.pn = pn; }
        else { decode((int)L - 352, 16, 10, pm, pn); u.pm = pm; u.pn = pn >= 8 ? pn + 1 : pn; }
        return true;
    }
    __device__ __forceinline__ void a_ready(const pg8::Unit&) const {}
    __device__ __forceinline__ void done(const pg8::Unit&) const {}
};
struct OneUnit {
    int pm, pn;
    __host__ __device__ bool next(int i, pg8::Unit& u) const { if (i != 0) return false; u.pm = pm; u.pn = pn; return true; }
    __device__ __forceinline__ void a_ready(const pg8::Unit&) const {}
    __device__ __forceinline__ void done(const pg8::Unit&) const {}
};

template <bool PERMIN>
__device__ __forceinline__ void transpose_item(const float* W, int K, int N, bf16* WT, LAS float* scr, int item, int lane) {
    const int nblk = N / 32, kb = item / nblk, nb = item % nblk, k0 = 64 * kb, n0 = 32 * nb;
    float wv[32];
#pragma unroll
    for (int i = 0; i < 32; ++i) wv[i] = __builtin_nontemporal_load(&W[(size_t)(k0 + 2 * i + (lane >> 5)) * N + n0 + (lane & 31)]);
#pragma unroll
    for (int i = 0; i < 32; ++i) scr[(2 * i + (lane >> 5)) * 33 + (lane & 31)] = wv[i];
    asm volatile("s_waitcnt lgkmcnt(0)" ::: "memory");
    const int c = lane & 7;
#pragma unroll
    for (int j = 0; j < 4; ++j) { const int n = (lane >> 3) + 8 * j; const LAS float* s = scr + (8 * c) * 33 + n;
        u32x4 o; o.x = pk2(s[0 * 33], s[1 * 33]); o.y = pk2(s[2 * 33], s[3 * 33]); o.z = pk2(s[4 * 33], s[5 * 33]); o.w = pk2(s[6 * 33], s[7 * 33]);
        *(u32x4*)(WT + (size_t)(PERMIN ? perm_in(n0 + n) : n0 + n) * K + k0 + 8 * c) = o; }
    asm volatile("s_waitcnt lgkmcnt(0)" ::: "memory");
}
template <bool SILU, bool PERMOUT>
__device__ __forceinline__ void gemv_item(LAS unsigned char* lds, const float* W, int N, int n0, const float* v0, const float* v1, int vs, const float* bias, float* out, int ldo, const int wave_s__) {
    LAS float* vl = (LAS float*)lds;
    LAS float* red = (LAS float*)(lds + 36864);
    int tid_l = TIDX; asm volatile("" : "+v"(tid_l));
    const int tid = tid_l, lane = tid & 63, w = tid >> 6;
    __syncthreads();
    {   float vv[NG * 1024 / NT];
#pragma unroll
        for (int r = 0; r < NG * 1024 / NT; ++r) { const int i = tid + NT * r, g = i >> 10, k = i & 1023; vv[r] = (g == 0) ? v0[k] : v1[(size_t)(g - 1) * vs + k]; }
#pragma unroll
        for (int r = 0; r < NG * 1024 / NT; ++r) { float v = vv[r]; if (SILU) v = v * sigmoidf_(v); vl[tid + NT * r] = v; } }
    __syncthreads();
    float acc[NG];
#pragma unroll
    for (int g = 0; g < NG; ++g) acc[g] = 0.f;
    const float* wp = W + (size_t)(w * 128) * N + n0 + lane;
    for (int k8 = 0; k8 < 128; k8 += 32) {
        float wv[32];
#pragma unroll
        for (int j = 0; j < 32; ++j) wv[j] = __builtin_nontemporal_load(&wp[(size_t)(k8 + j) * N]);
#pragma unroll
        for (int j = 0; j < 32; ++j)
#pragma unroll
            for (int g = 0; g < NG; ++g) acc[g] += vl[g * 1024 + w * 128 + k8 + j] * wv[j];
    }
#pragma unroll
    for (int g = 0; g < NG; ++g) red[(w * NG + g) * 64 + lane] = acc[g];
    __syncthreads();
    for (int i = tid; i < NG * 64; i += NT) { const int g = i >> 6, ln = i & 63; float s = 0.f;
#pragma unroll
        for (int ww = 0; ww < 8; ++ww) s += red[(ww * NG + g) * 64 + ln];
        out[(size_t)g * ldo + (PERMOUT ? perm_in(n0 + ln) : n0 + ln)] = s + (bias ? bias[n0 + ln] : 0.f); }
}

__device__ __forceinline__ f32x4 mfma16(bf16x8 a, bf16x8 b, f32x4 c) { return __builtin_amdgcn_mfma_f32_16x16x32_bf16(a, b, c, 0, 0, 0); }
constexpr int KS_STRIDE = 72, VT_STRIDE = 72;
constexpr int LDS_KS = 0, LDS_VT = 128 * KS_STRIDE * 2;
__device__ __forceinline__ float asf(unsigned u) { return __builtin_bit_cast(float, u); }

__device__ __forceinline__ void store_vt(LAS bf16* VT, int key, int c8, const u32x4 raw) { *(LAS u32x4*)(VT + key * VT_STRIDE + 8 * c8) = raw; }
typedef short v4i16_t __attribute__((ext_vector_type(4)));
__device__ __forceinline__ v4i16_t vtr(LAS const bf16* p) { return __builtin_amdgcn_ds_read_tr16_b64_v4i16((LAS v4i16_t*)p); }
struct Pre { u32x4 r[4]; };
__device__ __forceinline__ void pf_z(Pre& p, const bf16* Z, int rowbase, int kcol, int vcol, int tid) {
#pragma unroll
    for (int r = 0; r < 2; ++r) { const int idx = tid + NT * r, key = idx >> 3, c8 = idx & 7; const bf16* q = Z + (size_t)(rowbase + key) * DIN + 8 * c8;
        p.r[2 * r] = *(const u32x4*)(q + kcol); p.r[2 * r + 1] = *(const u32x4*)(q + vcol); }
}
__device__ __forceinline__ void st_z(const Pre& p, LAS bf16* Ks, LAS bf16* VT, int tid) {
#pragma unroll
    for (int r = 0; r < 2; ++r) { const int idx = tid + NT * r, key = idx >> 3, c8 = idx & 7; *(LAS u32x4*)(Ks + key * KS_STRIDE + 8 * c8) = p.r[2 * r]; store_vt(VT, key, c8, p.r[2 * r + 1]); }
}
template <int HD>
__device__ __forceinline__ void pf_cache(Pre& p, const float* CK, const float* CV, int rs, int tid) {
    const int key = tid >> 3, c8 = tid & 7, sub = HD == 64 ? 0 : (c8 >> 2) * 32, i0 = HD == 64 ? 4 * c8 : 4 * (c8 & 3);
    const float* kp = CK + (size_t)key * rs + sub + i0; const float* vp = CV + (size_t)key * rs + 8 * c8;
    p.r[0] = *(const u32x4*)kp; p.r[1] = *(const u32x4*)(kp + HD / 2); p.r[2] = *(const u32x4*)vp; p.r[3] = *(const u32x4*)(vp + 4);
}
__device__ __forceinline__ u32x4 pack_f32x8(const u32x4 a, const u32x4 b) { u32x4 w; w.x = pk2(asf(a.x), asf(a.y)); w.y = pk2(asf(a.z), asf(a.w)); w.z = pk2(asf(b.x), asf(b.y)); w.w = pk2(asf(b.z), asf(b.w)); return w; }
__device__ __forceinline__ void st_cache(const Pre& p, LAS bf16* Ks, LAS bf16* VT, int tid) {
    const int key = tid >> 3, c8 = tid & 7; const u32x4 e = p.r[0], o = p.r[1];
    u32x4 w; w.x = pk2(asf(e.x), asf(o.x)); w.y = pk2(asf(e.y), asf(o.y)); w.z = pk2(asf(e.z), asf(o.z)); w.w = pk2(asf(e.w), asf(o.w));
    *(LAS u32x4*)(Ks + key * KS_STRIDE + 8 * c8) = w; store_vt(VT, key, c8, pack_f32x8(p.r[2], p.r[3]));
}
__device__ __forceinline__ void pf_state(Pre& p, const float* S0, int tid) { const float* vp = S0 + (size_t)(tid >> 3) * 64 + 8 * (tid & 7); p.r[2] = *(const u32x4*)vp; p.r[3] = *(const u32x4*)(vp + 4); }
__device__ __forceinline__ void st_state(const Pre& p, LAS bf16* Ks, LAS bf16* VT, int tid) {
    const int key = tid >> 3, c8 = tid & 7; u32x4 r = {0u, 0u, 0u, 0u};
    if ((key >> 3) == c8) { const unsigned one = 0x3F80u << (16 * (key & 1)); const int wd = (key & 7) >> 1; r.x = wd == 0 ? one : 0u; r.y = wd == 1 ? one : 0u; r.z = wd == 2 ? one : 0u; r.w = wd == 3 ? one : 0u; }
    *(LAS u32x4*)(Ks + key * KS_STRIDE + 8 * c8) = r; store_vt(VT, key, c8, pack_f32x8(p.r[2], p.r[3]));
}

constexpr int LDS_SLOT = 2 * 128 * KS_STRIDE * 2, LDS_TAB = 2 * LDS_SLOT;
template <int NV>
__device__ __forceinline__ void softmax_step(float (&p)[NV], float& m, float& l, f32x4 (&o)[4], bool force) {
    bool big = force;
#pragma unroll
    for (int j = 0; j < NV; ++j) big |= p[j] > 8.f;
    if (__builtin_amdgcn_ballot_w64(big) != 0ull) {
        float mx = p[0];
#pragma unroll
        for (int j = 1; j < NV; ++j) mx = fmaxf(mx, p[j]);
        mx = max_x16(mx); mx = max_x32(mx);
        const bool mv = force || mx > 8.f;
        const float d = mv ? mx : 0.f, al = ex2(-d); m += d; l *= al;
#pragma unroll
        for (int j = 0; j < NV; ++j) p[j] -= d;
#pragma unroll
        for (int n = 0; n < 4; ++n) o[n] = o[n] * al;
    }
    float sum = 0.f;
#pragma unroll
    for (int j = 0; j < NV; ++j) { p[j] = ex2(p[j]); sum += p[j]; }
    l += sum;
}
template <int MODE, int KS>
__device__ __forceinline__ void attn_compute(LAS const bf16* Ks, LAS const bf16* VT, int nk, int kind, int kp0, int qpos, const bf16x8 (&qf)[2],
                                             f32x4 (&o)[4], f32x4 (&o2)[4], float& m1, float& l1, float& m2, float& l2, float c1, float lgf2, float lgb2, int g, int lq, bool first, LAS const float* tab) {
    constexpr int NTL = KS / 16, NV = KS / 4, NH = KS / 32;
    const f32x4 zero = {0.f, 0.f, 0.f, 0.f};
    float Af = 0.f, Ab = 0.f;
    if (MODE == 0 && kind == 2) { Af = ex2(lgf2 * (float)(qpos - kp0)); Ab = ex2(lgb2 * (float)(kp0 - qpos)); }
    for (int kk = 0; kk < nk / KS; ++kk) {
        f32x4 s[NTL], t[NTL];
        const f32x4 nm1 = {-m1, -m1, -m1, -m1}, nm2 = {-m2, -m2, -m2, -m2};
#pragma unroll
        for (int tt = 0; tt < NTL; ++tt) {
            LAS const bf16* kr = Ks + (kk * KS + tt * 16 + lq) * KS_STRIDE + 8 * g;
            const bf16x8 k0 = *(LAS const bf16x8*)kr, k1 = *(LAS const bf16x8*)(kr + 32);
            if (MODE == 2) { s[tt] = mfma16(k0, qf[0], nm1); t[tt] = mfma16(k1, qf[1], nm2); }
            else { s[tt] = mfma16(k0, qf[0], MODE == 1 ? nm1 : zero); s[tt] = mfma16(k1, qf[1], s[tt]); t[tt] = zero; }
        }
        float p[NV], p2[NV];
        if (MODE == 0) {
            if (kind == 2) {
                const int qlo = __builtin_amdgcn_readfirstlane(qpos - lq), klo = kp0 + kk * KS;
                if (klo + KS - 1 < qlo) {
#pragma unroll
                    for (int tt = 0; tt < NTL; ++tt) { const f32x4 cf = *(LAS const f32x4*)(tab + kk * KS + tt * 16 + 4 * g);
#pragma unroll
                        for (int i = 0; i < 4; ++i) p[tt * 4 + i] = s[tt][i] * (Af * cf[i]); }
                } else if (klo > qlo + 15) {
#pragma unroll
                    for (int tt = 0; tt < NTL; ++tt) { const f32x4 cb = *(LAS const f32x4*)(tab + 128 + kk * KS + tt * 16 + 4 * g);
#pragma unroll
                        for (int i = 0; i < 4; ++i) p[tt * 4 + i] = s[tt][i] * (Ab * cb[i]); }
                } else {
#pragma unroll
                    for (int tt = 0; tt < NTL; ++tt) { const int j0 = kk * KS + tt * 16 + 4 * g; const f32x4 cf = *(LAS const f32x4*)(tab + j0), cb = *(LAS const f32x4*)(tab + 128 + j0);
#pragma unroll
                        for (int i = 0; i < 4; ++i) { const int d = qpos - kp0 - j0 - i; const float f = d > 0 ? Af * cf[i] : (d < 0 ? Ab * cb[i] : 0.25f); p[tt * 4 + i] = s[tt][i] * f; } }
                }
            } else {
#pragma unroll
                for (int tt = 0; tt < NTL; ++tt)
#pragma unroll
                    for (int i = 0; i < 4; ++i) p[tt * 4 + i] = s[tt][i] * c1;
            }
        } else {
            bool masked = false;
            if (MODE == 1 && kind == 1) { const int qlo = __builtin_amdgcn_readfirstlane(qpos - lq), klo = kp0 + kk * KS; masked = (qlo + 15 - klo > 128) || (klo + KS - 1 - qlo > 128); }
#pragma unroll
            for (int tt = 0; tt < NTL; ++tt)
#pragma unroll
                for (int i = 0; i < 4; ++i) {
                    float v = s[tt][i];
                    if (MODE == 1 && masked) { const int d = qpos - (kp0 + kk * KS + tt * 16 + 4 * g + i); if (d > 128 || d < -128) v = -INFINITY; }
                    p[tt * 4 + i] = v;
                }
            softmax_step<NV>(p, m1, l1, o, MODE == 2 && first && kk == 0);
            if (MODE == 2) {
#pragma unroll
                for (int tt = 0; tt < NTL; ++tt)
#pragma unroll
                    for (int i = 0; i < 4; ++i) p2[tt * 4 + i] = t[tt][i];
                softmax_step<NV>(p2, m2, l2, o2, first && kk == 0);
            }
        }
        bf16x8 pf[NH], pf2[NH];
#pragma unroll
        for (int hh = 0; hh < NH; ++hh) {
            u32x4 w; w.x = pk2(p[8 * hh], p[8 * hh + 1]); w.y = pk2(p[8 * hh + 2], p[8 * hh + 3]); w.z = pk2(p[8 * hh + 4], p[8 * hh + 5]); w.w = pk2(p[8 * hh + 6], p[8 * hh + 7]);
            pf[hh] = __builtin_bit_cast(bf16x8, w); pf2[hh] = pf[hh];
            if (MODE == 2) { u32x4 w2; w2.x = pk2(p2[8 * hh], p2[8 * hh + 1]); w2.y = pk2(p2[8 * hh + 2], p2[8 * hh + 3]); w2.z = pk2(p2[8 * hh + 4], p2[8 * hh + 5]); w2.w = pk2(p2[8 * hh + 6], p2[8 * hh + 7]);
                pf2[hh] = __builtin_bit_cast(bf16x8, w2); }
        }
#pragma unroll
        for (int hh = 0; hh < NH; ++hh)
#pragma unroll
            for (int n = 0; n < 4; ++n) {
                LAS const bf16* vr = VT + (kk * KS + hh * 32 + 4 * g + (lq >> 2)) * VT_STRIDE + 16 * n + 4 * (lq & 3);
                const v4i16_t lo = vtr(vr), hi = vtr(vr + 16 * VT_STRIDE);
                const bf16x8 vf = {lo[0], lo[1], lo[2], lo[3], hi[0], hi[1], hi[2], hi[3]};
                o[n] = mfma16(vf, pf[hh], o[n]);
                if (MODE == 2) o2[n] = mfma16(vf, pf2[hh], o2[n]);
            }
    }
}

template <int MODE>
__device__ __forceinline__ void attn_unit(const Args& a, LAS unsigned char* lds, int layer, int seq, int h, int qb, const int wave_s__) {
    int tid_l = TIDX; asm volatile("" : "+v"(tid_l));
    const int tid = tid_l, lane = tid & 63, w = tid >> 6, g = lane >> 4, lq = lane & 15;
    const bool lat = seq >= 16; const int b = lat ? seq - 16 : seq, L = lat ? 1024 : 256, row0 = lat ? NCTX + b * 1024 : b * 256;
    const bf16* Z = (const bf16*)(a.ws + WS_Z); bf16* Y = (bf16*)(a.ws + WS_Y);
    LAS bf16* Ks = (LAS bf16*)(lds + LDS_KS); LAS bf16* VT = (LAS bf16*)(lds + LDS_VT);
    const int q0 = qb * 128, qpos = q0 + w * 16 + lq;
    const int kvh = MODE == 1 ? (h >> 1) : h;
    const int qcol = (MODE == 0 ? 0 : MODE == 1 ? 1536 : 2048) + h * 64, kcol = (MODE == 0 ? 256 : MODE == 1 ? 1792 : 2304) + kvh * 64, vcol = (MODE == 0 ? 512 : MODE == 1 ? 1920 : 2560) + kvh * 64;
    float m1 = 0.f, l1 = 0.f, m2 = 0.f, l2 = 0.f, c1 = 0.f, lgf2 = 0.f, lgb2 = 0.f;
    float xdf = 0.f, xdb = 0.f;
    if (MODE == 0) { xdf = a.in[I_RDEC][(layer * 2 + 0) * 4 + h]; xdb = a.in[I_RDEC][(layer * 2 + 1) * 4 + h]; }
    else if (MODE == 1) { c1 = 0.125f * LOG2E; m1 = a.in[I_SINK][layer * 4 + h] * LOG2E; l1 = (g == 0) ? 1.f : 0.f; }
    else { c1 = 0.17677669529663687f * LOG2E; }
    bf16x8 qf[2];
    { const bf16* qp = Z + (size_t)(row0 + qpos) * DIN + qcol;
#pragma unroll
      for (int ks = 0; ks < 2; ++ks) {
          u32x4 raw = *(const u32x4*)(qp + 32 * ks + 8 * g);
          if (MODE != 0) { float x[8]; unpack8(raw, x);
#pragma unroll
              for (int j = 0; j < 8; ++j) x[j] *= c1;
              raw = pack8(x); }
          qf[ks] = __builtin_bit_cast(bf16x8, raw);
      } }
    float lpa = 0.f, lpb = 0.f;
    if (MODE == 2 && lane < 32) { const float* lv = a.in[I_DLAM] + layer * 128; lpa = lv[lane] * lv[32 + lane]; lpb = lv[64 + lane] * lv[96 + lane]; }
    f32x4 o[4], o2[4];
#pragma unroll
    for (int n = 0; n < 4; ++n) { o[n] = (f32x4){0.f, 0.f, 0.f, 0.f}; o2[n] = (f32x4){0.f, 0.f, 0.f, 0.f}; }
    int ka0 = 0, ka1 = L;
    if (MODE == 1 && lat) { ka0 = q0 - 128 < 0 ? 0 : q0 - 128; ka1 = q0 + 256 > L ? L : q0 + 256; }
    const int kindA = MODE == 0 ? 2 : (MODE == 1 && lat) ? 1 : 0;
    const int nzc = (ka1 - ka0) >> 7, ntot = nzc + (lat ? (MODE == 0 ? 2 : 4) : 0);
    const float* CK = a.in[MODE == 1 ? I_CSK : I_CDK]; const float* CV = a.in[MODE == 1 ? I_CSV : I_CDV];
    const int rs = MODE == 1 ? 128 : 256; const size_t cbase = (size_t)(b * 4 + layer) * 256 * rs + kvh * 64;
    const float* S0 = a.in[I_SRET] + ((size_t)((b * 4 + layer) * 2) * 4 + h) * 4096;
    LAS const float* tab = (LAS const float*)(lds + LDS_TAB);
    LAS bf16* K0 = (LAS bf16*)lds; LAS bf16* V0 = K0 + 128 * KS_STRIDE; LAS bf16* K1 = (LAS bf16*)(lds + LDS_SLOT); LAS bf16* V1 = K1 + 128 * KS_STRIDE;
#define ATT_PF(P, cn) do { if ((cn) < ntot) { \
        if ((cn) < nzc) pf_z(P, Z, row0 + ka0 + 128 * (cn), kcol, vcol, tid); \
        else if (MODE == 0) pf_state(P, S0 + (size_t)((cn) - nzc) * 4 * 4096, tid); \
        else pf_cache<MODE == 1 ? 64 : 32>(P, CK + cbase + (size_t)((cn) - nzc) * 64 * rs, CV + cbase + (size_t)((cn) - nzc) * 64 * rs, rs, tid); } } while (0)
#define ATT_ST(P, c, KS_, VS_) do { if ((c) < nzc) st_z(P, KS_, VS_, tid); else if (MODE == 0) st_state(P, KS_, VS_, tid); else st_cache(P, KS_, VS_, tid); } while (0)
#define ATT_CMP(c, KS_, VS_) do { \
        if ((c) < nzc) attn_compute<MODE, (MODE == 2 ? 64 : 128)>(KS_, VS_, 128, kindA, ka0 + 128 * (c), qpos, qf, o, o2, m1, l1, m2, l2, c1, lgf2, lgb2, g, lq, (c) == 0, tab); \
        else if (MODE == 0) { const float rf = ((c) == nzc) ? ex2(lgf2 * (float)(qpos + 1)) : ex2(lgb2 * (float)(L - qpos)); \
            attn_compute<MODE, 64>(KS_, VS_, 64, 3, 0, qpos, qf, o, o2, m1, l1, m2, l2, rf, lgf2, lgb2, g, lq, false, tab); } \
        else attn_compute<MODE, 64>(KS_, VS_, 64, 0, 0, qpos, qf, o, o2, m1, l1, m2, l2, c1, lgf2, lgb2, g, lq, false, tab); } while (0)
    Pre preA, preB;
    ATT_PF(preA, 0); ATT_PF(preB, 1);
    if (MODE == 0) { lgf2 = -log1pf(__expf(-xdf)) * LOG2E; lgb2 = -log1pf(__expf(-xdb)) * LOG2E; }
    __syncthreads();
    if (MODE == 0 && tid < 256) ((LAS float*)(lds + LDS_TAB))[tid] = 0.125f * (tid < 128 ? ex2(-lgf2 * (float)tid) : ex2(lgb2 * (float)(tid - 128)));
    ATT_ST(preA, 0, K0, V0); ATT_PF(preA, 2);
    __syncthreads();
#pragma unroll 1
    for (int c = 0; c < ntot; c += 2) {
        if (c + 1 < ntot) { ATT_ST(preB, c + 1, K1, V1); ATT_PF(preB, c + 3); }
        ATT_CMP(c, K0, V0);
        __syncthreads();
        if (c + 1 < ntot) {
            if (c + 2 < ntot) { ATT_ST(preA, c + 2, K0, V0); ATT_PF(preA, c + 4); }
            ATT_CMP(c + 1, K1, V1);
            __syncthreads();
        }
    }
#undef ATT_PF
#undef ATT_ST
#undef ATT_CMP
    const size_t row = (size_t)(row0 + qpos);
    if (MODE == 0) {
        float s = 0.f;
#pragma unroll
        for (int n = 0; n < 4; ++n) s += (o[n][0] + o[n][1]) + (o[n][2] + o[n][3]);
        s = sum_x16(s); s = sum_x32(s);
        const float mu = s * (1.f / 64.f); float q = 0.f;
#pragma unroll
        for (int n = 0; n < 4; ++n)
#pragma unroll
            for (int i = 0; i < 4; ++i) { const float d = o[n][i] - mu; q += d * d; }
        q = sum_x16(q); q = sum_x32(q);
        const float rs = rsqrtf(q * (1.f / 64.f) + EPS);
        f32x4 gnv[4]; u32x2 gzv[4];
#pragma unroll
        for (int n = 0; n < 4; ++n) { const int dv = 16 * n + 4 * g; gnv[n] = *(const f32x4*)(a.in[I_RGN] + layer * 256 + h * 64 + dv); gzv[n] = *(const u32x2*)(Z + row * DIN + 768 + h * 64 + dv); }
#pragma unroll
        for (int n = 0; n < 4; ++n) {
            const int dv = 16 * n + 4 * g; const f32x4 gn = gnv[n];
            const u32x2 gz = gzv[n];
            const float z0 = bflo(gz.x), z1 = bfhi(gz.x), z2 = bflo(gz.y), z3 = bfhi(gz.y);
            const float y0 = (o[n][0] - mu) * rs * gn[0] * (z0 * sigmoidf_(z0)), y1 = (o[n][1] - mu) * rs * gn[1] * (z1 * sigmoidf_(z1));
            const float y2 = (o[n][2] - mu) * rs * gn[2] * (z2 * sigmoidf_(z2)), y3 = (o[n][3] - mu) * rs * gn[3] * (z3 * sigmoidf_(z3));
            u32x2 wv; wv.x = pk2(y0, y1); wv.y = pk2(y2, y3);
            *(u32x2*)(Y + row * DM + h * 64 + dv) = wv;
        }
    } else if (MODE == 1) {
        float lt = l1; lt = sum_x16(lt); lt = sum_x32(lt);
        const float inv = rcp_(lt);
#pragma unroll
        for (int n = 0; n < 4; ++n) { u32x2 wv; wv.x = pk2(o[n][0] * inv, o[n][1] * inv); wv.y = pk2(o[n][2] * inv, o[n][3] * inv);
            *(u32x2*)(Y + row * DM + 512 + h * 64 + 16 * n + 4 * g) = wv; }
    } else {
        float lt1 = l1; lt1 = sum_x16(lt1); lt1 = sum_x32(lt1);
        float lt2 = l2; lt2 = sum_x16(lt2); lt2 = sum_x32(lt2);
        float pa = wave_sum(lpa), pb = wave_sum(lpb);
        const float linit = 0.8f - 0.6f * __expf(-0.3f * (float)layer), lam = __expf(pa) - __expf(pb) + linit;
        const float i1 = rcp_(lt1), i2 = lam * rcp_(lt2); float q = 0.f;
#pragma unroll
        for (int n = 0; n < 4; ++n)
#pragma unroll
            for (int i = 0; i < 4; ++i) { const float v = o[n][i] * i1 - o2[n][i] * i2; o[n][i] = v; q += v * v; }
        q = sum_x16(q); q = sum_x32(q);
        const float rs = rsqrtf(q * (1.f / 64.f) + EPS) * (1.f - linit);
        f32x4 dgn[4];
#pragma unroll
        for (int n = 0; n < 4; ++n) dgn[n] = *(const f32x4*)(a.in[I_DNG] + layer * 64 + 16 * n + 4 * g);
#pragma unroll
        for (int n = 0; n < 4; ++n) { const int dv = 16 * n + 4 * g; const f32x4 gn = dgn[n];
            u32x2 wv; wv.x = pk2(o[n][0] * rs * gn[0], o[n][1] * rs * gn[1]); wv.y = pk2(o[n][2] * rs * gn[2], o[n][3] * rs * gn[3]);
            *(u32x2*)(Y + row * DM + 768 + h * 64 + dv) = wv; }
    }
}

__device__ __forceinline__ void ret_state_unit(const Args& a, LAS unsigned char* lds, int layer, int b, int h, const int wave_s__) {
    int tid_l = TIDX; asm volatile("" : "+v"(tid_l));
    const int tid = tid_l; const bf16* Z = (const bf16*)(a.ws + WS_Z);
    LAS bf16* Kl = (LAS bf16*)lds; LAS bf16* Vl = (LAS bf16*)(lds + 32768); LAS float* WF = (LAS float*)(lds + 65536); LAS float* WB = (LAS float*)(lds + 66560);
    const float xf = a.in[I_RDEC][(layer * 2 + 0) * 4 + h], xb = a.in[I_RDEC][(layer * 2 + 1) * 4 + h];
    const float lgf2 = -log1pf(__expf(-xf)) * LOG2E, lgb2 = -log1pf(__expf(-xb)) * LOG2E;
    __syncthreads();
    for (int idx = tid; idx < 256 * 8; idx += NT) { const int key = idx >> 3, c8 = idx & 7; const bf16* p = Z + (size_t)(b * 256 + key) * DIN + h * 64 + 8 * c8;
        *(LAS u32x4*)(Kl + key * 64 + 8 * c8) = *(const u32x4*)(p + 256); *(LAS u32x4*)(Vl + key * 64 + 8 * c8) = *(const u32x4*)(p + 512); }
    if (tid < 256) { WF[tid] = 0.125f * ex2(lgf2 * (float)(255 - tid)); WB[tid] = 0.125f * ex2(lgb2 * (float)tid); }
    __syncthreads();
    const int dk = tid >> 3, dv0 = (tid & 7) * 8;
    float af[8], ab[8];
#pragma unroll
    for (int i = 0; i < 8; ++i) { af[i] = 0.f; ab[i] = 0.f; }
    for (int s = 0; s < 256; ++s) {
        const float kv = bf2f(Kl[s * 64 + dk]), kf = kv * WF[s], kb = kv * WB[s];
        float v[8]; unpack8(*(LAS const u32x4*)(Vl + s * 64 + dv0), v);
#pragma unroll
        for (int i = 0; i < 8; ++i) { af[i] += kf * v[i]; ab[i] += kb * v[i]; }
    }
    float* of = a.out + O_SRET + ((size_t)((b * 4 + layer) * 2 + 0) * 4 + h) * 4096 + dk * 64 + dv0;
    float* ob = a.out + O_SRET + ((size_t)((b * 4 + layer) * 2 + 1) * 4 + h) * 4096 + dk * 64 + dv0;
    *(f32x4*)of = (f32x4){af[0], af[1], af[2], af[3]}; *(f32x4*)(of + 4) = (f32x4){af[4], af[5], af[6], af[7]};
    *(f32x4*)ob = (f32x4){ab[0], ab[1], ab[2], ab[3]}; *(f32x4*)(ob + 4) = (f32x4){ab[4], ab[5], ab[6], ab[7]};
}

__device__ __forceinline__ void publish_count(unsigned* cnt, bool leader) {
    asm volatile("s_waitcnt vmcnt(0)" ::: "memory"); __syncthreads();
    if (leader) __hip_atomic_fetch_add((GAS unsigned*)cnt, 1u, __ATOMIC_RELAXED, __HIP_MEMORY_SCOPE_AGENT);
}
__device__ __forceinline__ void wait_count(unsigned* cnt, unsigned target, bool leader) {
    if (leader) { unsigned sp = 0; while (__hip_atomic_load((GAS unsigned*)cnt, __ATOMIC_RELAXED, __HIP_MEMORY_SCOPE_AGENT) < target && ++sp < (1u << 22)) __builtin_amdgcn_s_sleep(2);
        __builtin_amdgcn_fence(__ATOMIC_ACQUIRE, "agent"); asm volatile("s_waitcnt vmcnt(0)" ::: "memory"); }
    __syncthreads();
}
constexpr int LA_XC = 0, LA_XCF = 18432, LA_WT = 51200, LA_WTOT = 88064, LA_CW = 96256;
__device__ __forceinline__ void lru_a_unit(const Args& a, LAS unsigned char* lds, int layer, int seq, int n, int ci, const int wave_s__) {
    int tid_l = TIDX; asm volatile("" : "+v"(tid_l));
    const int tid = tid_l, lane = tid & 63, w = tid >> 6, g = lane >> 4, lq = lane & 15;
    const bool lat = seq >= 16; const int b = lat ? seq - 16 : seq, L = lat ? 1024 : 256, row0 = lat ? NCTX + b * 1024 : b * 256, t0 = ci * 128;
    const bf16* Z = (const bf16*)(a.ws + WS_Z);
    LAS bf16* XC = (LAS bf16*)(lds + LA_XC); LAS float* XCF = (LAS float*)(lds + LA_XCF); LAS bf16* WT = (LAS bf16*)(lds + LA_WT);
    LAS f32x2* WTOT = (LAS f32x2*)(lds + LA_WTOT); LAS float* CW = (LAS float*)(lds + LA_CW);
    const int ct = tid >> 2, c16 = (tid & 3) * 16;
    u32x4 xr[4][2];
#pragma unroll
    for (int j = 0; j < 4; ++j) { const int tt = t0 + ct - 2 + j;
        if (tt >= 0 && tt < L) { const bf16* p = Z + (size_t)(row0 + tt) * DIN + 1024 + n * 64 + c16; xr[j][0] = *(const u32x4*)p; xr[j][1] = *(const u32x4*)(p + 8); }
        else { xr[j][0] = (u32x4){0u, 0u, 0u, 0u}; xr[j][1] = (u32x4){0u, 0u, 0u, 0u}; } }
    u32x4 wq[4];
#pragma unroll
    for (int m = 0; m < 4; ++m) wq[m] = *(const u32x4*)((const bf16*)(a.ws + WS_WLRU) + ((size_t)((layer * 2 + (m >> 1)) * 2 + (m & 1)) * 4 + n) * 4096 + tid * 8);
    float pba[2][4], pbx[2][4], plam[2][4];
#pragma unroll
    for (int dd = 0; dd < 2; ++dd)
#pragma unroll
        for (int nt = 0; nt < 4; ++nt) { const size_t pofs = (size_t)(layer * 2 + dd) * 256 + n * 64 + 16 * nt + lq; pba[dd][nt] = a.in[I_LBA][pofs]; pbx[dd][nt] = a.in[I_LBX][pofs]; plam[dd][nt] = a.in[I_LLAM][pofs]; }
    float cwv = 0.f; if (tid < 320) { const int j = tid >> 6, c = tid & 63; cwv = j < 4 ? a.in[I_LCW][(layer * 4 + j) * 256 + n * 64 + c] : a.in[I_LCB][layer * 256 + n * 64 + c]; }
    __syncthreads();
    if (tid < 320) CW[tid] = cwv;
#pragma unroll
    for (int m = 0; m < 4; ++m) *(LAS u32x4*)(WT + (m * 64 + (tid >> 3)) * 72 + (tid & 7) * 8) = wq[m];
    __syncthreads();
    {   float acc[16];
#pragma unroll
        for (int i = 0; i < 4; ++i) { const f32x4 cb = *(LAS const f32x4*)(CW + 256 + c16 + 4 * i); acc[4 * i] = cb[0]; acc[4 * i + 1] = cb[1]; acc[4 * i + 2] = cb[2]; acc[4 * i + 3] = cb[3]; }
#pragma unroll
        for (int j = 0; j < 4; ++j) { float x[16]; { float x0[8], x1[8]; unpack8(xr[j][0], x0); unpack8(xr[j][1], x1);
#pragma unroll
                for (int i = 0; i < 8; ++i) { x[i] = x0[i]; x[8 + i] = x1[i]; } }
#pragma unroll
            for (int i = 0; i < 4; ++i) { const f32x4 cw = *(LAS const f32x4*)(CW + j * 64 + c16 + 4 * i);
                acc[4 * i] += cw[0] * x[4 * i]; acc[4 * i + 1] += cw[1] * x[4 * i + 1]; acc[4 * i + 2] += cw[2] * x[4 * i + 2]; acc[4 * i + 3] += cw[3] * x[4 * i + 3]; } }
        u32x4 w0, w1; w0.x = pk2(acc[0], acc[1]); w0.y = pk2(acc[2], acc[3]); w0.z = pk2(acc[4], acc[5]); w0.w = pk2(acc[6], acc[7]);
        w1.x = pk2(acc[8], acc[9]); w1.y = pk2(acc[10], acc[11]); w1.z = pk2(acc[12], acc[13]); w1.w = pk2(acc[14], acc[15]);
        *(LAS u32x4*)(XC + ct * 72 + c16) = w0; *(LAS u32x4*)(XC + ct * 72 + c16 + 8) = w1;
#pragma unroll
        for (int i = 0; i < 4; ++i) *(LAS f32x4*)(XCF + ct * 64 + c16 + 4 * i) = (f32x4){acc[4 * i], acc[4 * i + 1], acc[4 * i + 2], acc[4 * i + 3]};
    }
    __syncthreads();
    LAS const bf16* xrow = XC + (16 * w + lq) * 72 + 8 * g;
    const bf16x8 x0 = *(LAS const bf16x8*)xrow, x1 = *(LAS const bf16x8*)(xrow + 32);
    float hf[4][4];
    float* HS = (float*)(a.ws + WS_HS); float* PF = (float*)(a.ws + WS_PF); float* PB = (float*)(a.ws + WS_PB);
    f32x2* TOT = (f32x2*)(a.ws + WS_TOT) + ((size_t)((seq * 4 + n) * 8 + ci) * 2) * 64;
#pragma unroll 1
    for (int dir = 0; dir < 2; ++dir) {
        float P[4][4], hh[4][4];
        float PT[4], HT[4];
#pragma unroll
        for (int nt = 0; nt < 4; ++nt) {
            const f32x4 zero = {0.f, 0.f, 0.f, 0.f};
            LAS const bf16* wa = WT + ((dir * 2 + 0) * 64 + 16 * nt + lq) * 72 + 8 * g; LAS const bf16* wx = WT + ((dir * 2 + 1) * 64 + 16 * nt + lq) * 72 + 8 * g;
            f32x4 Ga = mfma16(x0, *(LAS const bf16x8*)wa, zero); Ga = mfma16(x1, *(LAS const bf16x8*)(wa + 32), Ga);
            f32x4 Gx = mfma16(x0, *(LAS const bf16x8*)wx, zero); Gx = mfma16(x1, *(LAS const bf16x8*)(wx + 32), Gx);
            const float ba = dir == 0 ? pba[0][nt] : pba[1][nt], bx = dir == 0 ? pbx[0][nt] : pbx[1][nt], lmv = dir == 0 ? plam[0][nt] : plam[1][nt];
            const float sp8 = 8.f * 0.6931471805599453f * __log2f(1.f + __expf(-lmv));
            float av[4], uv[4];
#pragma unroll
            for (int i = 0; i < 4; ++i) { const int t = 16 * w + 4 * g + i;
                const float r = sigmoidf_(Ga[i] + ba), ig = sigmoidf_(Gx[i] + bx), la = -r * sp8; av[i] = __expf(la);
                const float x2 = 2.f * la;
                const float ser = -x2 * (1.f + x2 * (0.5f + x2 * (0.16666667f + x2 * (0.041666668f + x2 * (0.0083333338f + x2 * 0.0013888889f)))));
                const float om = x2 > -0.25f ? ser : 1.f - av[i] * av[i];
                uv[i] = __builtin_amdgcn_sqrtf(fmaxf(om, 0.f)) * ig * XCF[t * 64 + 16 * nt + lq]; }
            float pp = 1.f, h = 0.f;
#pragma unroll
            for (int i = 0; i < 4; ++i) { const int ii = dir == 0 ? i : 3 - i; h = av[ii] * h + uv[ii]; pp *= av[ii]; P[nt][ii] = pp; hh[nt][ii] = h; }
            PT[nt] = pp; HT[nt] = h;
        }
        const int rk = dir == 0 ? g : 3 - g;
        float Pe[4], He[4];
#pragma unroll
        for (int nt = 0; nt < 4; ++nt) {
#pragma unroll
            for (int k = 1; k <= 2; k <<= 1) { const int src = ((dir == 0 ? lane - 16 * k : lane + 16 * k) & 63) << 2;
                const float Pp = asf_((unsigned)__builtin_amdgcn_ds_bpermute(src, (int)asu_(PT[nt]))), hp = asf_((unsigned)__builtin_amdgcn_ds_bpermute(src, (int)asu_(HT[nt])));
                if (rk >= k) { HT[nt] = PT[nt] * hp + HT[nt]; PT[nt] = PT[nt] * Pp; } }
            const int src = ((dir == 0 ? lane - 16 : lane + 16) & 63) << 2;
            Pe[nt] = asf_((unsigned)__builtin_amdgcn_ds_bpermute(src, (int)asu_(PT[nt]))); He[nt] = asf_((unsigned)__builtin_amdgcn_ds_bpermute(src, (int)asu_(HT[nt])));
            if (rk == 0) { Pe[nt] = 1.f; He[nt] = 0.f; }
            if (rk == 3) WTOT[(w * 2 + dir) * 64 + 16 * nt + lq] = (f32x2){PT[nt], HT[nt]};
        }
        __syncthreads();
#pragma unroll
        for (int nt = 0; nt < 4; ++nt) {
            float Pw = 1.f, hw = 0.f;
#pragma unroll
            for (int k = 0; k < 8; ++k) { const int w2 = dir == 0 ? k : 7 - k; const bool before = dir == 0 ? (w2 < w) : (w2 > w);
                const f32x2 e = WTOT[(w2 * 2 + dir) * 64 + 16 * nt + lq]; if (before) { hw = e.x * hw + e.y; Pw = e.x * Pw; } }
            const float Pex = Pe[nt] * Pw, hex = Pe[nt] * hw + He[nt];
            const int ch = n * 64 + 16 * nt + lq;
#pragma unroll
            for (int i = 0; i < 4; ++i) { const size_t idx = (size_t)(row0 + t0 + 16 * w + 4 * g + i) * 256 + ch;
                const float hv = P[nt][i] * hex + hh[nt][i], pv = P[nt][i] * Pex;
                if (dir == 0) { hf[nt][i] = hv; st_wt(PF + idx, pv); } else { st_wt(HS + idx, hf[nt][i] + hv); st_wt(PB + idx, pv); }
                if (rk == 3 && w == (dir == 0 ? 7 : 0) && i == (dir == 0 ? 3 : 0)) { float* tp = (float*)(TOT + dir * 64 + 16 * nt + lq); st_wt(tp, pv); st_wt(tp + 1, hv); } }
        }
    }
    publish_count((unsigned*)(a.ws + WS_CTL) + CW_LRU + layer * 128 + seq * 4 + n, tid == 0);
}
__device__ __forceinline__ void lru_b_unit(const Args& a, LAS unsigned char* lds, int layer, int seq, int n, int ci, const int wave_s__) {
    int tid_l = TIDX; asm volatile("" : "+v"(tid_l));
    const int tid = tid_l;
    const bool lat = seq >= 16; const int b = lat ? seq - 16 : seq, L = lat ? 1024 : 256, row0 = lat ? NCTX + b * 1024 : b * 256, nc = L / 128;
    unsigned* cnt = (unsigned*)(a.ws + WS_CTL) + CW_LRU + layer * 128 + seq * 4 + n;
    wait_count(cnt, (unsigned)nc, tid == 0);
    const bf16* Z = (const bf16*)(a.ws + WS_Z); bf16* Y = (bf16*)(a.ws + WS_Y);
    const float* HS = (const float*)(a.ws + WS_HS); const float* PF = (const float*)(a.ws + WS_PF); const float* PB = (const float*)(a.ws + WS_PB);
    f32x4 hs[4], pf[4], pb[4]; u32x2 gz[4];
#pragma unroll
    for (int r = 0; r < 4; ++r) { const int idx = tid + NT * r, t = ci * 128 + (idx >> 4), c4 = (idx & 15) * 4; const size_t row = (size_t)(row0 + t);
        hs[r] = *(const f32x4*)(HS + row * 256 + n * 64 + c4); pf[r] = *(const f32x4*)(PF + row * 256 + n * 64 + c4); pb[r] = *(const f32x4*)(PB + row * 256 + n * 64 + c4);
        gz[r] = *(const u32x2*)(Z + row * DIN + 1280 + n * 64 + c4); }
    LAS float* CF = (LAS float*)lds; LAS float* CB = CF + 64;
    const f32x2* TOT = (const f32x2*)(a.ws + WS_TOT) + (size_t)((seq * 4 + n) * 8) * 2 * 64;
    if (tid < 128) { const int dir = tid >> 6, c = tid & 63, ch = n * 64 + c;
        float cv = lat ? a.in[I_SLRU][(size_t)((b * 4 + layer) * 2 + dir) * 256 + ch] : 0.f; float mine = cv;
        f32x2 ev[8];
#pragma unroll
        for (int k = 0; k < 8; ++k) ev[k] = k < nc ? TOT[(size_t)(k * 2 + dir) * 64 + c] : (f32x2){1.f, 0.f};
#pragma unroll
        for (int k = 0; k < 8; ++k) { const int cj = dir == 0 ? k : 7 - k; if (cj < nc) { if (cj == ci) mine = cv; cv = ev[cj].x * cv + ev[cj].y; } }
        (dir == 0 ? CF : CB)[c] = mine;
        if (!lat && ci == 0) a.out[O_SLRU + (size_t)((b * 4 + layer) * 2 + dir) * 256 + ch] = cv; }
    __syncthreads();
#pragma unroll
    for (int r = 0; r < 4; ++r) { const int idx = tid + NT * r, t = ci * 128 + (idx >> 4), c4 = (idx & 15) * 4; const size_t row = (size_t)(row0 + t);
        const f32x4 cf = *(LAS const f32x4*)(CF + c4), cb = *(LAS const f32x4*)(CB + c4);
        const float gv[4] = {bflo(gz[r].x), bfhi(gz[r].x), bflo(gz[r].y), bfhi(gz[r].y)};
        float y[4];
#pragma unroll
        for (int e = 0; e < 4; ++e) { const float u3 = 0.7978845608028654f * (gv[e] + 0.044715f * gv[e] * gv[e] * gv[e]), th = 1.f - 2.f * rcp_(1.f + __expf(2.f * u3));
            y[e] = (hs[r][e] + pf[r][e] * cf[e] + pb[r][e] * cb[e]) * (0.5f * gv[e] * (1.f + th)); }
        u32x2 wv; wv.x = pk2(y[0], y[1]); wv.y = pk2(y[2], y[3]);
        *(u32x2*)(Y + row * DM + 256 + n * 64 + c4) = wv; }
}

constexpr int U_GEMM = 0, U_LRUA_LAT = 16, U_LRUA_CTX = 272, U_DIFF_LAT = 400, U_RET_LAT = 656, U_SWA_LAT = 912, U_RET_CTX = 1168, U_SWA_CTX = 1296, U_RST = 1424, U_LRUB_LAT = 1488, U_LRUB_CTX = 1744, U_DIFF_CTX = 1872, U_END = 2000;
__device__ __forceinline__ void mix_phase(const Args& a0, LAS unsigned char* lds, int layer_in, const int wave_s__, const int xcc) {
    volatile LAS int* sh = (volatile LAS int*)(lds + LDS_MISC);
    unsigned* ctr = (unsigned*)(a0.ws + WS_CTL) + 64 * (1 + layer_in);
    unsigned* dcnt = (unsigned*)(a0.ws + WS_CTL) + 64 * (9 + layer_in);
    unsigned* ctrq = (unsigned*)(a0.ws + WS_CTL) + 2048 + layer_in * 512;
    int qtry = 0; bool head_done = false;
#define MIX_CLAIM(dst) do { int u_ = U_END; \
        if (!head_done) { const int v_ = (int)atomicAdd(ctr, 1u); if (v_ < 16) u_ = v_; else head_done = true; } \
        while (u_ == U_END && qtry < 8) { const int q_ = (xcc + qtry) & 7; const int v_ = (int)atomicAdd(ctrq + 64 * q_, 1u); \
            if (v_ < 248) { \
                if (v_ < 32) u_ = U_LRUA_LAT + q_ * 32 + v_; else if (v_ < 48) u_ = U_LRUA_CTX + q_ * 16 + (v_ - 32); else if (v_ < 80) u_ = U_DIFF_LAT + q_ * 32 + (v_ - 48); \
                else if (v_ < 112) u_ = U_RET_LAT + q_ * 32 + (v_ - 80); else if (v_ < 144) u_ = U_SWA_LAT + q_ * 32 + (v_ - 112); else if (v_ < 160) u_ = U_RET_CTX + q_ * 16 + (v_ - 144); \
                else if (v_ < 176) u_ = U_SWA_CTX + q_ * 16 + (v_ - 160); else if (v_ < 184) u_ = U_RST + q_ * 8 + (v_ - 176); else if (v_ < 216) u_ = U_LRUB_LAT + q_ * 32 + (v_ - 184); \
                else if (v_ < 232) u_ = U_LRUB_CTX + q_ * 16 + (v_ - 216); else u_ = U_DIFF_CTX + q_ * 16 + (v_ - 232); \
            } else ++qtry; } \
        dst = u_; } while (0)
    int nxt = U_END;
    if (TIDX == 0) MIX_CLAIM(nxt);
    for (;;) {
        __syncthreads();
        if (TIDX == 0) sh[0] = nxt;
        __syncthreads();
        const int u = sh[0];
        if (u >= U_END) break;
        if (TIDX == 0) MIX_CLAIM(nxt);
        auto kp = __builtin_amdgcn_kernarg_segment_ptr(); asm volatile("" : "+s"(kp));
        const Args& a = *(const Args*)kp;
        int layer = layer_in; asm volatile("" : "+s"(layer));
        if (u < U_LRUA_LAT) {
            unsigned char* wsl = a.ws;
            pg8::Gemm gm{(const bf16*)(wsl + WS_XB), (const bf16*)(wsl + WS_WIN) + (size_t)layer * DIN * DM, NTOK, DIN, DM}; OneUnit S{u, 8};
            EpiIn E{(bf16*)(wsl + WS_Z), (const float*)(wsl + WS_SS), (const float*)(wsl + WS_B1) + (size_t)layer * NG * DIN, a.out, (const f32x4*)(wsl + WS_CS64), (const f32x4*)(wsl + WS_CS32), layer};
            pg8::gemm_phase<EpiIn, OneUnit, true, true>(lds, gm, S, E, wave_s__);
            asm volatile("s_waitcnt vmcnt(0)" ::: "memory"); __syncthreads();
            if (TIDX == 0) { __builtin_amdgcn_fence(__ATOMIC_RELEASE, "agent"); asm volatile("s_waitcnt vmcnt(0)" ::: "memory"); __hip_atomic_fetch_add((GAS unsigned*)dcnt, 1u, __ATOMIC_RELAXED, __HIP_MEMORY_SCOPE_AGENT); }
        }
        else if (u < U_LRUA_CTX) { const int r = u - U_LRUA_LAT; lru_a_unit(a, lds, layer, 16 + (r >> 5), (r >> 3) & 3, r & 7, wave_s__); }
        else if (u < U_DIFF_LAT) { const int r = u - U_LRUA_CTX; lru_a_unit(a, lds, layer, r >> 3, (r >> 1) & 3, r & 1, wave_s__); }
        else if (u < U_RET_LAT) { const int r = u - U_DIFF_LAT; attn_unit<2>(a, lds, layer, 16 + (r >> 5), (r >> 3) & 3, r & 7, wave_s__); }
        else if (u < U_SWA_LAT) { const int r = u - U_RET_LAT; attn_unit<0>(a, lds, layer, 16 + (r >> 5), (r >> 3) & 3, r & 7, wave_s__); }
        else if (u < U_RET_CTX) { const int r = u - U_SWA_LAT; attn_unit<1>(a, lds, layer, 16 + (r >> 5), (r >> 3) & 3, r & 7, wave_s__); }
        else if (u < U_SWA_CTX) { const int r = u - U_RET_CTX; attn_unit<0>(a, lds, layer, r >> 3, (r >> 1) & 3, r & 1, wave_s__); }
        else if (u < U_RST) { const int r = u - U_SWA_CTX; attn_unit<1>(a, lds, layer, r >> 3, (r >> 1) & 3, r & 1, wave_s__); }
        else if (u < U_LRUB_LAT) { const int r = u - U_RST; ret_state_unit(a, lds, layer, r >> 2, r & 3, wave_s__); }
        else if (u < U_LRUB_CTX) { const int r = u - U_LRUB_LAT; lru_b_unit(a, lds, layer, 16 + (r >> 5), (r >> 3) & 3, r & 7, wave_s__); }
        else if (u < U_DIFF_CTX) { const int r = u - U_LRUB_CTX; lru_b_unit(a, lds, layer, r >> 3, (r >> 1) & 3, r & 1, wave_s__); }
        else { const int r = u - U_DIFF_CTX;
            wait_count(dcnt, 16u, TIDX == 0);
            attn_unit<2>(a, lds, layer, r >> 3, (r >> 1) & 3, r & 1, wave_s__); }
    }
#undef MIX_CLAIM
}

__device__ __forceinline__ void prep_transposes(const Args& a, LAS unsigned char* lds, int l, int vb, int nb, const int wave_s__) {
    int tid_l = TIDX; asm volatile("" : "+v"(tid_l));
    const int lane = tid_l & 63, wave = tid_l >> 6;
    unsigned char* ws = a.ws;
    LAS float* scr = (LAS float*)(lds + wave * 16384);
    constexpr int IT_IN = (DM / 64) * (DIN / 32), IT_OUT = (DM / 64) * (DM / 32), IT_F1 = (DM / 64) * (DFF / 32), IT_F2 = (DFF / 64) * (DM / 32), IT_L = IT_IN + IT_OUT + IT_F1 + IT_F2;
    for (int it = vb * 8 + wave; it < IT_L; it += nb * 8) { int r = it;
        if (r < IT_IN) { transpose_item<true>(a.in[I_WIN] + (size_t)l * DM * DIN, DM, DIN, (bf16*)(ws + WS_WIN) + (size_t)l * DIN * DM, scr, r, lane); continue; } r -= IT_IN;
        if (r < IT_OUT) { transpose_item<false>(a.in[I_WOUT] + (size_t)l * DM * DM, DM, DM, (bf16*)(ws + WS_WOUT) + (size_t)l * DM * DM, scr, r, lane); continue; } r -= IT_OUT;
        if (r < IT_F1) { transpose_item<false>(a.in[I_WFF1] + (size_t)l * DM * DFF, DM, DFF, (bf16*)(ws + WS_WFF1) + (size_t)l * DFF * DM, scr, r, lane); continue; } r -= IT_F1;
        transpose_item<false>(a.in[I_WFF2] + (size_t)l * DFF * DM, DFF, DM, (bf16*)(ws + WS_WFF2) + (size_t)l * DM * DFF, scr, r, lane); }
}
__device__ __forceinline__ void prep_bias(const Args& a, LAS unsigned char* lds, int l, int vb, int nb, const int wave_s__) {
    unsigned char* ws = a.ws; const float* m = (const float*)(ws + WS_MOD) + (size_t)l * NG * NMOD;
    for (int r = vb; r < DIN / 64 + DFF / 64; r += nb) {
        if (r < DIN / 64) gemv_item<false, true>(lds, a.in[I_WIN] + (size_t)l * DM * DIN, DIN, r * 64, m, m + NMOD, NMOD, nullptr, (float*)(ws + WS_B1) + (size_t)l * NG * DIN, DIN, wave_s__);
        else gemv_item<false, false>(lds, a.in[I_WFF1] + (size_t)l * DM * DFF, DFF, (r - DIN / 64) * 64, m + 3072, m + NMOD + 3072, NMOD, nullptr, (float*)(ws + WS_B2) + (size_t)l * NG * DFF, DFF, wave_s__); }
}

#define XB_TMO      128
#define XB_XCNT(j)  (256  + 64 * (j))
#define XB_XSUB(j)  (1280 + 64 * (j))
#define XB_XGEN(j)  (2304 + 64 * (j))
#define XB_TOP      3328
#define XB_TOPGEN   3392
#define XCD_BAR_WORDS 3456
#define XB_SPIN_CAP (1u << 18)

__device__ __forceinline__ unsigned xb_ld(unsigned* p)              { return __hip_atomic_load(p, __ATOMIC_RELAXED, __HIP_MEMORY_SCOPE_AGENT); }
__device__ __forceinline__ unsigned xb_add(unsigned* p, unsigned v) { return __hip_atomic_fetch_add(p, v, __ATOMIC_RELAXED, __HIP_MEMORY_SCOPE_AGENT); }
__device__ __forceinline__ unsigned xb_xcc_id() { return (unsigned)__builtin_amdgcn_s_getreg((3 << 11) | 20) & 0xFu; }
#define XB_SPIN(cond, bar) do { unsigned _sp = 0; while (cond) { __builtin_amdgcn_s_sleep(1); \
    if ((++_sp & 255u) == 0u) { if (xb_ld(&(bar)[XB_TMO])) break; if (_sp > XB_SPIN_CAP) { atomicAdd(&(bar)[XB_TMO], 1u); break; } } } } while (0)

struct XcdBarrier {
    unsigned* bar; unsigned x;
    volatile LAS unsigned* st;
};

__device__ __forceinline__ XcdBarrier xcd_barrier_post(unsigned* bar, volatile LAS unsigned* st, const int wave_s__) {
    XcdBarrier b; b.bar = bar; b.x = xb_xcc_id(); b.st = st;
    if (TIDX == 0) (void)xb_add(&bar[XB_XCNT(b.x)], 1u);
    return b;
}
__device__ __forceinline__ void xcd_barrier_complete(unsigned* bar, unsigned x, unsigned& nloc, unsigned& nx) {
    const unsigned G = gridDim.x * gridDim.y * gridDim.z;
    unsigned sum, cnt, mine, sp = 0u;
    for (;;) {
        sum = 0u; cnt = 0u; mine = 0u;
#pragma unroll
        for (unsigned j = 0; j < 16; ++j) { const unsigned c = xb_ld(&bar[XB_XCNT(j)]); sum += c; cnt += (c > 0u) ? 1u : 0u; mine = (j == x) ? c : mine; }
        if (sum == G) break;
        __builtin_amdgcn_s_sleep(1);
        if ((++sp & 255u) == 0u) { if (xb_ld(&bar[XB_TMO])) break; if (sp > XB_SPIN_CAP) { atomicAdd(&bar[XB_TMO], 1u); break; } }
    }
    nloc = mine > 0u ? mine : 1u; nx = cnt > 0u ? cnt : 1u;
}

__device__ __forceinline__ void xcd_barrier(const XcdBarrier& b, const int wave_s__) {
    asm volatile("s_waitcnt vmcnt(0)" ::: "memory");
    __syncthreads();
    if (TIDX == 0) {
        unsigned* bar = b.bar;
        __builtin_amdgcn_s_waitcnt(0);
        unsigned nloc = b.st[0], nx = b.st[1];
        const unsigned old = xb_add(&bar[XB_XSUB(b.x)], 1u);
        const unsigned gen = old / nloc;
        if (old + 1u == (gen + 1u) * nloc) {
            __builtin_amdgcn_fence(__ATOMIC_RELEASE, "agent");
            asm volatile("s_waitcnt vmcnt(0)" ::: "memory");
            const unsigned og = xb_add(&bar[XB_TOP], 1u);
            const unsigned tg = og / nx;
            if (og + 1u == (tg + 1u) * nx) xb_add(&bar[XB_TOPGEN], 1u);
            else XB_SPIN(xb_ld(&bar[XB_TOPGEN]) == tg, bar);
            __builtin_amdgcn_fence(__ATOMIC_ACQUIRE, "agent");
            xb_add(&bar[XB_XGEN(b.x)], 1u);
            asm volatile("s_waitcnt vmcnt(0)" ::: "memory");
        } else {
            XB_SPIN(xb_ld(&bar[XB_XGEN(b.x)]) == gen, bar);
            __builtin_amdgcn_fence(__ATOMIC_ACQUIRE, "agent");
            asm volatile("s_waitcnt vmcnt(0)" ::: "memory");
        }
    }
    __syncthreads();
}

__global__ void __launch_bounds__(NT, 2) fwd_megakernel(Args a) {
    extern __shared__ __attribute__((aligned(16))) unsigned char lds_raw[];
    LAS unsigned char* lds = (LAS unsigned char*)lds_raw;
    cg::grid_group grid = cg::this_grid();
    const int wave_s__ = __builtin_amdgcn_readfirstlane((int)threadIdx.x >> 6);
    const int tid = TIDX, lane = tid & 63, wave = wave_s__, G = gridDim.x, bid = blockIdx.x;
    if (tid < 64) ((LAS unsigned*)(lds + LDS_MISC))[tid] = 0u;
    __syncthreads();
    const XcdBarrier bar = xcd_barrier_post((unsigned*)(a.ws + WS_CTL) + CW_BAR, (volatile LAS unsigned*)(lds + LDS_MISC) + 8, wave_s__);
#define GRID_BAR() do { XcdBarrier bb_ = bar; asm volatile("" : "+s"(bb_.x)); xcd_barrier(bb_, wave_s__); } while (0)
    const int gw = bid * 8 + wave, NGW = G * 8;
    {
    unsigned char* ws = a.ws;
    float* MOD = (float*)(ws + WS_MOD); float* GM = (float*)(ws + WS_GM); float* B1 = (float*)(ws + WS_B1); float* B2 = (float*)(ws + WS_B2);
    float* SS = (float*)(ws + WS_SS); float* X = (float*)(ws + WS_X); bf16* XB = (bf16*)(ws + WS_XB); bf16* Z = (bf16*)(ws + WS_Z); bf16* Y = (bf16*)(ws + WS_Y); bf16* H = (bf16*)(ws + WS_H);
    bf16* WIN = (bf16*)(ws + WS_WIN); bf16* WOUT = (bf16*)(ws + WS_WOUT); bf16* WFF1 = (bf16*)(ws + WS_WFF1); bf16* WFF2 = (bf16*)(ws + WS_WFF2);

    for (int it = bid; it < 4 * (NMOD / 64); it += G) { const int l = it / (NMOD / 64), n0 = (it % (NMOD / 64)) * 64;
        gemv_item<true, false>(lds, a.in[I_WADA] + (size_t)l * DM * NMOD, NMOD, n0, a.in[I_CCTX], a.in[I_C], DM, a.in[I_BADA] + (size_t)l * NMOD, MOD + (size_t)l * NG * NMOD, NMOD, wave_s__); }
    __syncthreads();
    prep_transposes(a, lds, 0, bid, G, wave_s__);
    for (int i = bid * NT + tid; i < 4 * 2 * 2 * 4 * 4096; i += G * NT) {
        const int c = i & 63, d = (i >> 6) & 63, nb = (i >> 12) & 3, gate = (i >> 14) & 1, ld = i >> 15;
        ((bf16*)(ws + WS_WLRU))[i] = (bf16)f2bf(a.in[gate ? I_LWX : I_LWA][((size_t)(ld * 4 + nb) * 64 + c) * 64 + d]); }
    for (int i = bid * NT + tid; i < 1024 * 32 + 1024 * 16; i += G * NT) {
        if (i < 1024 * 32) { const int pos = i >> 5, k = i & 31; const float inv = exp2f(-(float)(k & 15) * (13.287712379549449f / 16.f)); const float ang = (float)(k < 16 ? (pos >> 6) : (pos & 63)) * inv;
            ((f32x2*)(ws + WS_CS64))[i] = (f32x2){cosf(ang), sinf(ang)}; }
        else { const int j = i - 1024 * 32, pos = j >> 4, k = j & 15; const float inv = exp2f(-(float)(k & 7) * (13.287712379549449f / 8.f)); const float ang = (float)(k < 8 ? (pos >> 6) : (pos & 63)) * inv;
            ((f32x2*)(ws + WS_CS32))[j] = (f32x2){cosf(ang), sinf(ang)}; }
    }
    if (a.ws == nullptr) grid.sync();
    if (tid == 0) { unsigned nloc, nx; xcd_barrier_complete(bar.bar, bar.x, nloc, nx); bar.st[0] = nloc; bar.st[1] = nx; }
    __syncthreads();
    GRID_BAR();
    prep_bias(a, lds, 0, bid, G, wave_s__);
    for (int i = bid * NT + tid; i < 4 * 2 * NG * DM; i += G * NT) { const int k = i & 1023, g = (i >> 10) % NG, which = (i / (NG * DM)) & 1, l = i / (2 * NG * DM);
        GM[i] = a.in[which ? I_NMLPG : I_NMIXG][l * DM + k] * (1.f + MOD[((size_t)l * NG + g) * NMOD + (which ? 4096 : 1024) + k]); }
    for (int rowa = gw; rowa < NTOK; rowa += 2 * NGW) {
        f32x4 xv[2][4], ngv[4], scv[2][4]; bool ok[2];
#pragma unroll
        for (int j = 0; j < 4; ++j) ngv[j] = *(const f32x4*)(a.in[I_NMIXG] + 4 * lane + 256 * j);
#pragma unroll
        for (int q = 0; q < 2; ++q) { const int row = rowa + q * NGW; ok[q] = row < NTOK;
            if (ok[q]) { const float* xr = row < NCTX ? a.in[I_XP] + (size_t)row * DM : a.in[I_XS] + (size_t)(row - NCTX) * DM; const int g = grp_of_row(row);
#pragma unroll
                for (int j = 0; j < 4; ++j) { const int c = 4 * lane + 256 * j; xv[q][j] = __builtin_nontemporal_load((const f32x4*)(xr + c)); scv[q][j] = *(const f32x4*)(MOD + (size_t)g * NMOD + 1024 + c); } } }
#pragma unroll
        for (int q = 0; q < 2; ++q) if (ok[q]) { const int row = rowa + q * NGW;
            float s = 0.f;
#pragma unroll
            for (int j = 0; j < 4; ++j) { const int c = 4 * lane + 256 * j; const f32x4 v = xv[q][j], ng = ngv[j], sc = scv[q][j]; s += (v[0] * v[0] + v[1] * v[1]) + (v[2] * v[2] + v[3] * v[3]);
                { u32x2 xw; xw.x = pk2(v[0], v[1]); xw.y = pk2(v[2], v[3]); *(u32x2*)((bf16*)X + (size_t)row * DM + c) = xw; }
                u32x2 wv; wv.x = pk2(v[0] * ng[0] * (1.f + sc[0]), v[1] * ng[1] * (1.f + sc[1])); wv.y = pk2(v[2] * ng[2] * (1.f + sc[2]), v[3] * ng[3] * (1.f + sc[3]));
                *(u32x2*)(XB + (size_t)row * DM + c) = wv; }
            s = wave_sum(s);
            if (lane < 16) SS[(size_t)row * 16 + lane] = lane == 0 ? s : 0.f; }
    }
    }
    GRID_BAR();
#define FRESH_WS() unsigned char* wsl = a.ws; asm volatile("" : "+s"(wsl))
#pragma unroll 1
    for (int l = 0; l < 4; ++l) {
        {   FRESH_WS();
            pg8::Gemm gm{(const bf16*)(wsl + WS_XB), (const bf16*)(wsl + WS_WIN) + (size_t)l * DIN * DM, NTOK, DIN, DM}; InOrder S{G, bid};
            EpiIn E{(bf16*)(wsl + WS_Z), (const float*)(wsl + WS_SS), (const float*)(wsl + WS_B1) + (size_t)l * NG * DIN, a.out, (const f32x4*)(wsl + WS_CS64), (const f32x4*)(wsl + WS_CS32), l};
            pg8::gemm_phase<EpiIn, InOrder, true, true>(lds, gm, S, E, wave_s__); }
        GRID_BAR();
        mix_phase(a, lds, l, wave_s__, (int)bar.x);
        GRID_BAR();
        {   FRESH_WS();
            pg8::Gemm gm{(const bf16*)(wsl + WS_Y), (const bf16*)(wsl + WS_WOUT) + (size_t)l * DM * DM, NTOK, DM, DM}; pg8::StaticOrder S; S.init(NTOK, DM, G, bid);
            EpiRes E{(bf16*)(wsl + WS_X), (bf16*)(wsl + WS_XB), (float*)(wsl + WS_SS), (const float*)(wsl + WS_MOD) + (size_t)l * NG * NMOD + 2048, (const float*)(wsl + WS_GM) + (size_t)(l * 2 + 1) * NG * DM};
            pg8::gemm_phase<EpiRes, pg8::StaticOrder, true, true>(lds, gm, S, E, wave_s__); }
        if (l < 3) { const int nb = G > 192 ? G - 192 : G, vb = G > 192 ? bid - 192 : bid; if (vb >= 0) prep_bias(a, lds, l + 1, vb, nb, wave_s__); }
        GRID_BAR();
        {   FRESH_WS();
            pg8::Gemm gm{(const bf16*)(wsl + WS_XB), (const bf16*)(wsl + WS_WFF1) + (size_t)l * DFF * DM, NTOK, DFF, DM}; pg8::StaticOrder S; S.init(NTOK, DFF, G, bid);
            EpiFF1 E{(bf16*)(wsl + WS_H), (const float*)(wsl + WS_SS), (const float*)(wsl + WS_B2) + (size_t)l * NG * DFF};
            pg8::gemm_phase<EpiFF1, pg8::StaticOrder, true, true>(lds, gm, S, E, wave_s__); }
        GRID_BAR();
        {   FRESH_WS();
            pg8::Gemm gm{(const bf16*)(wsl + WS_H), (const bf16*)(wsl + WS_WFF2) + (size_t)l * DM * DFF, NTOK, DM, DFF}; pg8::StaticOrder S; S.init(NTOK, DM, G, bid);
            EpiRes E{(bf16*)(wsl + WS_X), (bf16*)(wsl + WS_XB), (float*)(wsl + WS_SS), (const float*)(wsl + WS_MOD) + (size_t)l * NG * NMOD + 5120, l < 3 ? (const float*)(wsl + WS_GM) + (size_t)((l + 1) * 2 + 0) * NG * DM : nullptr};
            pg8::gemm_phase<EpiRes, pg8::StaticOrder, true, true>(lds, gm, S, E, wave_s__); }
        if (l < 3) { const int nb = G > 192 ? G - 192 : G, vb = G > 192 ? bid - 192 : bid; if (vb >= 0) prep_transposes(a, lds, l + 1, vb, nb, wave_s__); }
        GRID_BAR();
    }
    FRESH_WS();
    int tid_f = TIDX; asm volatile("" : "+v"(tid_f));
    const int lane_f = tid_f & 63, gw_f = bid * 8 + (tid_f >> 6);
    for (int row = gw_f; row < NTOK; row += NGW) {
        const f32x4 sa = *(const f32x4*)((const float*)(wsl + WS_SS) + (size_t)row * 16 + 4 * (lane_f & 3));
        u32x2 xw[4]; f32x4 fgv[4];
#pragma unroll
        for (int j = 0; j < 4; ++j) { const int c = 4 * lane_f + 256 * j; xw[j] = *(const u32x2*)((const bf16*)(wsl + WS_X) + (size_t)row * DM + c); fgv[j] = *(const f32x4*)(a.in[I_FNG] + c); }
        float ps = (sa[0] + sa[1]) + (sa[2] + sa[3]);
        ps += asf_(__builtin_amdgcn_update_dpp(0, asu_(ps), 0xB1, 0xF, 0xF, true)); ps += asf_(__builtin_amdgcn_update_dpp(0, asu_(ps), 0x4E, 0xF, 0xF, true));
        const float rs = rsqrtf(ps * (1.f / DM) + EPS);
#pragma unroll
        for (int j = 0; j < 4; ++j) { const int c = 4 * lane_f + 256 * j; const f32x4 v = {bflo(xw[j].x), bfhi(xw[j].x), bflo(xw[j].y), bfhi(xw[j].y)};
            __builtin_nontemporal_store(v * rs * fgv[j], (f32x4*)(a.out + (size_t)row * DM + c)); }
    }
}

extern "C" void kernel_launch(void* const* d_in, const int* in_sizes, int n_in, void* d_out, int out_size, void* d_ws, size_t ws_size, hipStream_t stream) {
    static int grid = 0;
    if (grid == 0) {
        if (n_in != N_IN || ws_size < WS_END) { fprintf(stderr, "kernel_launch: expected %d inputs and >= %zu bytes of workspace, got %d / %zu\n", (int)N_IN, (size_t)WS_END, n_in, ws_size); grid = -1; return; }
        int dev = 0, cus = 0, per_cu = 0;
        (void)hipGetDevice(&dev); (void)hipDeviceGetAttribute(&cus, hipDeviceAttributeMultiprocessorCount, dev);
        if (hipFuncSetAttribute((const void*)fwd_megakernel, hipFuncAttributeMaxDynamicSharedMemorySize, LDS_BYTES) != hipSuccess) { fprintf(stderr, "kernel_launch: hipFuncSetAttribute failed\n"); grid = -1; return; }
        if (hipOccupancyMaxActiveBlocksPerMultiprocessor(&per_cu, (const void*)fwd_megakernel, NT, LDS_BYTES) != hipSuccess || per_cu < 1) { fprintf(stderr, "kernel_launch: occupancy query gave %d\n", per_cu); per_cu = 1; }
        (void)hipGetLastError();
        grid = cus * 1;
        fprintf(stderr, "kernel_launch: grid %d (cus %d, per_cu %d)\n", grid, cus, per_cu);
    }
    if (grid < 0) return;
    (void)hipMemsetAsync((char*)d_ws + WS_CTL, 0, 32768, stream);
    Args a{};
    for (int i = 0; i < N_IN; ++i) a.in[i] = (const float*)d_in[i];
    a.out = (float*)d_out; a.ws = (unsigned char*)d_ws;
    void* args[] = {&a};
    hipError_t e = hipLaunchCooperativeKernel((const void*)fwd_megakernel, dim3(grid), dim3(NT), args, LDS_BYTES, stream);
    if (e != hipSuccess) fprintf(stderr, "kernel_launch: cooperative launch failed: %s (grid %d)\n", hipGetErrorString(e), grid);
}
```

```cpp
#include <hip/hip_runtime.h>
#include <hip/hip_cooperative_groups.h>
#include <cstdio>
#include <cstdint>
namespace cg = cooperative_groups;
#define TIDX ((int)(wave_s__ * 64 + (int)__builtin_amdgcn_mbcnt_hi(~0u, __builtin_amdgcn_mbcnt_lo(~0u, 0u))))
namespace pg8 {
#define PG8_LAS __attribute__((address_space(3)))
typedef unsigned short bf16_t;
typedef short bf16x8 __attribute__((ext_vector_type(8)));
typedef float f32x4 __attribute__((ext_vector_type(4)));
typedef unsigned u32x4 __attribute__((ext_vector_type(4)));
constexpr int BM = 256, BK = 64, HALF = 128, HTB = HALF * BK * 2  , STAGE_BYTES = 8 * HTB, NXCD = 8, WGM = 8;

__host__ __device__ __forceinline__ int lds_byte(int r, int c) { const int st = (r >> 4) * 2 + (c >> 5), rr = r & 15, cc = c & 31, ob = rr * 64 + cc * 2; return st * 1024 + (ob ^ (((ob >> 9) & 1) << 5)); }
__host__ __device__ __forceinline__ void stage_rc(int b, int& R, int& C) { const int st = b / 1024, sb = b % 1024, swz = sb ^ (((sb >> 9) & 1) << 5); R = (st >> 1) * 16 + swz / 64; C = (st & 1) * 32 + (swz % 64) / 2; }
__host__ __device__ __forceinline__ int perm32(int rho) { const int n = rho >> 4, i = rho & 15; return 8 * (i >> 2) + 4 * n + (i & 3); }

struct Unit { int pm, pn; };
struct Gemm { const bf16_t* A; const bf16_t* Bt; int M, N, K; };

struct StaticOrder {
    int nM, nN, nwg, G, c;
    __host__ __device__ void init(int M, int N, int G_, int c_) { nM = M / BM; nN = N / BM; nwg = nM * nN; G = G_; c = c_; }
    __host__ __device__ bool next(int i, Unit& u) const {
        const long L = (long)i * G + c; if (L >= nwg) return false;
        int wgid = (int)L; { const int q = nwg / NXCD, r = nwg % NXCD, xcd = wgid % NXCD, off = wgid / NXCD; wgid = (xcd < r ? xcd * (q + 1) : r * (q + 1) + (xcd - r) * q) + off; }
        const int nig = WGM * nN, gid = wgid / nig, fm = gid * WGM, gsz = (nM - fm) < WGM ? (nM - fm) : WGM;
        u.pm = fm + ((wgid % nig) % gsz); u.pn = (wgid % nig) / gsz; return true;
    }
    __device__ __forceinline__ void a_ready(const Unit&) const {}
    __device__ __forceinline__ void done(const Unit&) const {}
};
__device__ __forceinline__ unsigned cvt_pk_bf16(float lo, float hi) { unsigned r; asm volatile("v_cvt_pk_bf16_f32 %0, %1, %2" : "=v"(r) : "v"(lo), "v"(hi)); return r; }

template <class Epi, class Sched, bool ALIGN_EPI = false, bool SP2 = false>
__device__ __forceinline__ void gemm_phase(PG8_LAS unsigned char* lds, const Gemm g, const Sched& S, const Epi& E, const int wave_s__) {
    int tid_l = TIDX; asm volatile("" : "+v"(tid_l));
    const int tid = tid_l, wid = __builtin_amdgcn_readfirstlane(tid >> 6), lane = tid & 63, wr = wid >> 2, wc = wid & 3, fr = lane & 15, fq = lane >> 4;
    const int K = g.K, nt = K / BK;
    unsigned voffA[2], voffB[2];
#pragma unroll
    for (int i = 0; i < 2; ++i) { int R, C; stage_rc(tid * 16 + i * 8192, R, C); const int Rb = Epi::PERM ? ((R & ~31) + perm32(R & 31)) : R;
        voffA[i] = (unsigned)(R * K + C) * 2u; voffB[i] = (unsigned)(Rb * K + C) * 2u; }
    const size_t kstep = (size_t)(BK * 2);
    const size_t hstep = (size_t)HALF * K * 2;
    const size_t tstep = 2 * hstep;
    const unsigned ldsw = (unsigned)wid * 1024u;
    const int aoff = lds_byte(wr * 64 + fr, fq * 8), boff = lds_byte(wc * 32 + fr, fq * 8);
#define PG8_SA(b, h) (((b) * 2 + (h)) * HTB)
#define PG8_SB(b, h) ((4 + (b) * 2 + (h)) * HTB)
#define PG8_STAGE(bufoff, gbase, voff) do { _Pragma("unroll") for (int _i = 0; _i < 2; ++_i) \
        __builtin_amdgcn_global_load_lds((const unsigned*)((const char*)(gbase) + (voff)[_i]), (PG8_LAS unsigned*)(lds + (bufoff) + ldsw + _i * 8192), 16, 0, 0); } while (0)
#define PG8_LDA(dst, b, h) do { _Pragma("unroll") for (int m = 0; m < 4; ++m) _Pragma("unroll") for (int k = 0; k < 2; ++k) dst[m][k] = *(const PG8_LAS bf16x8*)(lds + PG8_SA(b, h) + aoff + m * 2048 + k * 1024); } while (0)
#define PG8_LDB(dst, b, h) do { _Pragma("unroll") for (int n = 0; n < 2; ++n) _Pragma("unroll") for (int k = 0; k < 2; ++k) dst[n][k] = *(const PG8_LAS bf16x8*)(lds + PG8_SB(b, h) + boff + n * 2048 + k * 1024); } while (0)
#define PG8_MMA(ai, bj, At, Bt) do { __builtin_amdgcn_s_setprio(1); _Pragma("unroll") for (int m = 0; m < 4; ++m) _Pragma("unroll") for (int n = 0; n < 2; ++n) _Pragma("unroll") for (int k = 0; k < 2; ++k) \
        acc[ai][bj][m][n] = __builtin_amdgcn_mfma_f32_16x16x32_bf16(Bt[n][k], At[m][k], acc[ai][bj][m][n], 0, 0, 0); __builtin_amdgcn_s_setprio(0); } while (0)
#define PG8_WAIT_V(n) asm volatile("s_waitcnt vmcnt(" #n ")" ::: "memory")
#define PG8_WAIT_L(n) asm volatile("s_waitcnt lgkmcnt(" #n ")" ::: "memory")
#define PG8_BAR __builtin_amdgcn_s_barrier()
#define PG8_SCHED __builtin_amdgcn_sched_barrier(0)
    Unit cur, nxt; int ui = 0;
    if (!S.next(0, cur)) return;
    f32x4 acc[2][2][4][2];
#pragma unroll
    for (int a = 0; a < 2; ++a)
#pragma unroll
        for (int b = 0; b < 2; ++b)
#pragma unroll
            for (int m = 0; m < 4; ++m)
#pragma unroll
                for (int n = 0; n < 2; ++n) acc[a][b][m][n] = (f32x4){0.f, 0.f, 0.f, 0.f};
    bf16x8 At[4][2], B0[2][2], B1[2][2];
    const char* cA = (const char*)g.A + (size_t)cur.pm * tstep; const char* cB = (const char*)g.Bt + (size_t)cur.pn * tstep;
    S.a_ready(cur);
    if constexpr (SP2) {
        PG8_STAGE(PG8_SB(0, 0), cB, voffB); PG8_STAGE(PG8_SB(0, 1), cB + hstep, voffB); PG8_STAGE(PG8_SA(0, 0), cA, voffA); PG8_STAGE(PG8_SA(0, 1), cA + hstep, voffA);
        if (wr == 1) PG8_BAR;
        PG8_WAIT_V(2); PG8_BAR;
        PG8_STAGE(PG8_SB(1, 0), cB + kstep, voffB); PG8_STAGE(PG8_SA(1, 0), cA + kstep, voffA); PG8_STAGE(PG8_SB(1, 1), cB + hstep + kstep, voffB);
        PG8_WAIT_V(6); PG8_BAR;
    } else {
        PG8_STAGE(PG8_SB(0, 0), cB, voffB); PG8_STAGE(PG8_SA(0, 0), cA, voffA); PG8_STAGE(PG8_SB(0, 1), cB + hstep, voffB); PG8_STAGE(PG8_SA(0, 1), cA + hstep, voffA);
        if (wr == 1) PG8_BAR;
        PG8_WAIT_V(4); PG8_BAR;
        PG8_STAGE(PG8_SB(1, 0), cB + kstep, voffB); PG8_STAGE(PG8_SA(1, 0), cA + kstep, voffA); PG8_STAGE(PG8_SB(1, 1), cB + hstep + kstep, voffB);
        PG8_WAIT_V(6); PG8_BAR;
    }
    for (;;) {
        const bool has_next = S.next(ui + 1, nxt);
        const char* nA = has_next ? (const char*)g.A + (size_t)nxt.pm * tstep : cA; const char* nB = has_next ? (const char*)g.Bt + (size_t)nxt.pn * tstep : cB;
        for (int t = 0; t < nt; t += 2) {
            const bool last = (t == nt - 2);
            const char* a1 = cA + (size_t)(t + 1) * kstep;
            const char* a2 = last ? nA : cA + (size_t)(t + 2) * kstep; const char* b2 = last ? nB : cB + (size_t)(t + 2) * kstep;
            const char* a3 = a2 + kstep; const char* b3 = b2 + kstep;
            if (last && has_next) S.a_ready(nxt);
            if constexpr (SP2) {
            PG8_LDB(B0, 0, 0); PG8_LDB(B1, 0, 1); PG8_SCHED; PG8_LDA(At, 0, 0); PG8_STAGE(PG8_SA(1, 1), a1 + hstep, voffA);
            PG8_WAIT_V(8); PG8_WAIT_L(0); PG8_BAR; PG8_MMA(0, 0, At, B0); PG8_MMA(0, 1, At, B1); PG8_BAR; PG8_SCHED;
            PG8_LDA(At, 0, 1); PG8_STAGE(PG8_SB(0, 0), b2, voffB); PG8_STAGE(PG8_SB(0, 1), b2 + hstep, voffB); PG8_STAGE(PG8_SA(0, 0), a2, voffA);
            PG8_WAIT_V(8); PG8_WAIT_L(0); PG8_BAR; PG8_MMA(1, 0, At, B0); PG8_MMA(1, 1, At, B1); PG8_BAR; PG8_SCHED;
            PG8_LDB(B0, 1, 0); PG8_LDB(B1, 1, 1); PG8_SCHED; PG8_LDA(At, 1, 0); PG8_STAGE(PG8_SA(0, 1), a2 + hstep, voffA);
            PG8_WAIT_V(8); PG8_WAIT_L(0); PG8_BAR; PG8_MMA(0, 0, At, B0); PG8_MMA(0, 1, At, B1); PG8_BAR; PG8_SCHED;
            PG8_LDA(At, 1, 1); PG8_STAGE(PG8_SB(1, 0), b3, voffB); PG8_STAGE(PG8_SB(1, 1), b3 + hstep, voffB); PG8_STAGE(PG8_SA(1, 0), a3, voffA);
            PG8_WAIT_V(8); PG8_WAIT_L(0); PG8_BAR; PG8_MMA(1, 0, At, B0); PG8_MMA(1, 1, At, B1); PG8_BAR; PG8_SCHED;
            } else {
            PG8_LDB(B0, 0, 0); PG8_SCHED; PG8_LDA(At, 0, 0); PG8_STAGE(PG8_SA(1, 1), a1 + hstep, voffA);
            PG8_WAIT_L(8); PG8_BAR; PG8_WAIT_L(0); PG8_MMA(0, 0, At, B0); PG8_BAR; PG8_SCHED;
            PG8_LDB(B1, 0, 1); PG8_STAGE(PG8_SB(0, 0), b2, voffB);
            PG8_BAR; PG8_WAIT_L(0); PG8_MMA(0, 1, At, B1); PG8_BAR;
            PG8_LDA(At, 0, 1); PG8_STAGE(PG8_SA(0, 0), a2, voffA);
            PG8_BAR; PG8_WAIT_L(0); PG8_MMA(1, 0, At, B0); PG8_BAR; PG8_SCHED;
            PG8_STAGE(PG8_SB(0, 1), b2 + hstep, voffB);
            PG8_WAIT_V(6); PG8_BAR; PG8_MMA(1, 1, At, B1); PG8_BAR;
            PG8_LDB(B0, 1, 0); PG8_SCHED; PG8_LDA(At, 1, 0); PG8_STAGE(PG8_SA(0, 1), a2 + hstep, voffA);
            PG8_WAIT_L(8); PG8_BAR; PG8_WAIT_L(0); PG8_MMA(0, 0, At, B0); PG8_BAR; PG8_SCHED;
            PG8_LDB(B1, 1, 1); PG8_STAGE(PG8_SB(1, 0), b3, voffB);
            PG8_BAR; PG8_WAIT_L(0); PG8_MMA(0, 1, At, B1); PG8_BAR;
            PG8_LDA(At, 1, 1); PG8_STAGE(PG8_SA(1, 0), a3, voffA);
            PG8_BAR; PG8_WAIT_L(0); PG8_MMA(1, 0, At, B0); PG8_BAR; PG8_SCHED;
            PG8_STAGE(PG8_SB(1, 1), b3 + hstep, voffB);
            PG8_WAIT_V(6); PG8_BAR; PG8_MMA(1, 1, At, B1); PG8_BAR;
            }
        }
        if constexpr (ALIGN_EPI) { if (wr == 0) PG8_BAR; }
        if constexpr (!Epi::AFTER_DRAIN) { E(acc, cur, wr, wc, fr, fq); S.done(cur); }
        if (!has_next) break;
#pragma unroll
        for (int a = 0; a < 2; ++a)
#pragma unroll
            for (int b = 0; b < 2; ++b)
#pragma unroll
                for (int m = 0; m < 4; ++m)
#pragma unroll
                    for (int n = 0; n < 2; ++n) acc[a][b][m][n] = (f32x4){0.f, 0.f, 0.f, 0.f};
        cur = nxt; cA = nA; cB = nB; ++ui;
        if constexpr (ALIGN_EPI) { if (wr == 1) PG8_BAR; }
    }
    PG8_WAIT_V(0);
    if constexpr (!ALIGN_EPI) { if (wr == 0) PG8_BAR; }
    PG8_BAR;
    if constexpr (Epi::AFTER_DRAIN) { E.fused(acc, cur, wr, wc, fr, fq, lds, wid, lane); S.done(cur); }
#undef PG8_SA
#undef PG8_SB
#undef PG8_STAGE
#undef PG8_LDA
#undef PG8_LDB
#undef PG8_MMA
#undef PG8_WAIT_V
#undef PG8_WAIT_L
#undef PG8_BAR
#undef PG8_SCHED
}
}

#define LAS __attribute__((address_space(3)))
typedef unsigned short bf16;
typedef short bf16x8 __attribute__((ext_vector_type(8)));
typedef float f32x4 __attribute__((ext_vector_type(4)));
typedef unsigned u32x4 __attribute__((ext_vector_type(4)));
typedef unsigned u32x2 __attribute__((ext_vector_type(2)));
typedef float f32x2 __attribute__((ext_vector_type(2)));

constexpr int DM = 1024, DIN = 2816, DFF = 4096, NTOK = 12288, NCTX = 4096, NG = 9, NMOD = 6144;
constexpr float EPS = 1e-6f, LOG2E = 1.4426950408889634f;
constexpr int NT = 512;
enum { I_XP = 0, I_XS, I_C, I_SRET, I_SLRU, I_CSK, I_CSV, I_CDK, I_CDV, I_CCTX, I_WADA, I_BADA, I_NMIXG, I_WIN, I_RDEC, I_RGN, I_LCW, I_LCB,
       I_LWA, I_LBA, I_LWX, I_LBX, I_LLAM, I_SINK, I_DLAM, I_DNG, I_WOUT, I_NMLPG, I_WFF1, I_WFF2, I_FNG, N_IN };
constexpr size_t O_YP = 0, O_YS = 4194304, O_SRET = 12582912, O_SLRU = 14680064, O_SWAK = 14712832, O_SWAV = 16809984, O_DK = 18907136, O_DV = 23101440;
constexpr size_t MiB = 1u << 20;
constexpr size_t WS_CTL = 0, WS_MOD = 1 * MiB, WS_GM = 2 * MiB, WS_B1 = 3 * MiB, WS_B2 = 4 * MiB, WS_CS64 = 5 * MiB, WS_CS32 = 5 * MiB + 512 * 1024, WS_SS = 6 * MiB,
                 WS_WIN = 8 * MiB, WS_WOUT = 30 * MiB, WS_WFF1 = 38 * MiB, WS_WFF2 = 70 * MiB, WS_X = 102 * MiB, WS_XB = 150 * MiB, WS_Z = 174 * MiB, WS_Y = 240 * MiB,
                 WS_H = 264 * MiB, WS_END = 360 * MiB;
constexpr size_t WS_WLRU = 7 * MiB;
constexpr size_t WS_HS = WS_H, WS_PF = WS_H + 16 * MiB, WS_PB = WS_H + 32 * MiB, WS_TOT = WS_H + 48 * MiB;
constexpr int CW_LRU = 1024;
constexpr int LDS_BYTES = 139264;
constexpr int LDS_MISC = 131072;
constexpr int CW_BAR = 4096;

struct Args { const float* in[N_IN]; float* out; unsigned char* ws; };

__device__ __forceinline__ unsigned f2bf(float f) { unsigned u = __builtin_bit_cast(unsigned, f); return (u + 0x7fffu + ((u >> 16) & 1u)) >> 16; }
typedef float f32x2_t __attribute__((ext_vector_type(2))); typedef __bf16 bf16x2_t __attribute__((ext_vector_type(2)));
__device__ __forceinline__ unsigned pk2(float lo, float hi) { const f32x2_t v = {lo, hi}; const bf16x2_t b = __builtin_convertvector(v, bf16x2_t); return __builtin_bit_cast(unsigned, b); }
__host__ __device__ __forceinline__ int perm_in(int c) {
    if (c >= 1536 && c < 1920) { const int i = c & 63; return (c & ~63) + (i < 32 ? 2 * i : 2 * (i - 32) + 1); }
    if (c >= 2048 && c < 2560) { const int i = c & 31; return (c & ~31) + (i < 16 ? 2 * i : 2 * (i - 16) + 1); }
    return c;
}
__device__ __forceinline__ float bflo(unsigned w) { return __builtin_bit_cast(float, w << 16); }
__device__ __forceinline__ float bfhi(unsigned w) { return __builtin_bit_cast(float, w & 0xffff0000u); }
__device__ __forceinline__ float bf2f(bf16 v) { return __builtin_bit_cast(float, (unsigned)v << 16); }
__device__ __forceinline__ void unpack8(const u32x4 r, float (&f)[8]) { f[0] = bflo(r.x); f[1] = bfhi(r.x); f[2] = bflo(r.y); f[3] = bfhi(r.y); f[4] = bflo(r.z); f[5] = bfhi(r.z); f[6] = bflo(r.w); f[7] = bfhi(r.w); }
__device__ __forceinline__ u32x4 pack8(const float (&f)[8]) { u32x4 r; r.x = pk2(f[0], f[1]); r.y = pk2(f[2], f[3]); r.z = pk2(f[4], f[5]); r.w = pk2(f[6], f[7]); return r; }
__device__ __forceinline__ float ex2(float x) { return __builtin_amdgcn_exp2f(x); }
__device__ __forceinline__ float asf_(unsigned u) { return __builtin_bit_cast(float, u); }
__device__ __forceinline__ unsigned asu_(float f) { return __builtin_bit_cast(unsigned, f); }
__device__ __forceinline__ float sum_x16(float v) { const auto r = __builtin_amdgcn_permlane16_swap(asu_(v), asu_(v), false, false); return asf_(r[0]) + asf_(r[1]); }
__device__ __forceinline__ float sum_x32(float v) { const auto r = __builtin_amdgcn_permlane32_swap(asu_(v), asu_(v), false, false); return asf_(r[0]) + asf_(r[1]); }
__device__ __forceinline__ float max_x16(float v) { const auto r = __builtin_amdgcn_permlane16_swap(asu_(v), asu_(v), false, false); return fmaxf(asf_(r[0]), asf_(r[1])); }
__device__ __forceinline__ float max_x32(float v) { const auto r = __builtin_amdgcn_permlane32_swap(asu_(v), asu_(v), false, false); return fmaxf(asf_(r[0]), asf_(r[1])); }
__device__ __forceinline__ float wave_sum(float v) {
    v += asf_(__builtin_amdgcn_update_dpp(0, asu_(v), 0xB1, 0xF, 0xF, true));
    v += asf_(__builtin_amdgcn_update_dpp(0, asu_(v), 0x4E, 0xF, 0xF, true));
    v += asf_(__builtin_amdgcn_update_dpp(0, asu_(v), 0x141, 0xF, 0xF, true));
    v += asf_(__builtin_amdgcn_update_dpp(0, asu_(v), 0x140, 0xF, 0xF, true));
    v = sum_x16(v); return sum_x32(v);
}
__device__ __forceinline__ float rcp_(float x) { return __builtin_amdgcn_rcpf(x); }
__device__ __forceinline__ float sigmoidf_(float x) { return rcp_(1.f + __expf(-x)); }
__device__ __forceinline__ int grp_of_tile(int pm) { return pm < 16 ? 0 : 1 + ((pm - 16) >> 2); }
__device__ __forceinline__ int grp_of_row(int row) { return row < NCTX ? 0 : 1 + ((row - NCTX) >> 10); }
__device__ __forceinline__ float rstd_of(const float* SS, int row) {
    const f32x4* sp = (const f32x4*)(SS + (size_t)row * 16); const f32x4 a = sp[0], b = sp[1], c = sp[2], d = sp[3];
    const float s = ((a.x + a.y) + (a.z + a.w)) + ((b.x + b.y) + (b.z + b.w)) + ((c.x + c.y) + (c.z + c.w)) + ((d.x + d.y) + (d.z + d.w));
    return rsqrtf(s * (1.f / DM) + EPS);
}
__device__ __forceinline__ float rstd_of4(const float* SS, int row, int fq) {
    const f32x4 a = *(const f32x4*)(SS + (size_t)row * 16 + 4 * fq);
    float s = (a.x + a.y) + (a.z + a.w); s = sum_x16(s); s = sum_x32(s);
    return rsqrtf(s * (1.f / DM) + EPS);
}
#define GAS __attribute__((address_space(1)))
__device__ __forceinline__ void st_wt(float* p, float v) { __hip_atomic_store((GAS float*)p, v, __ATOMIC_RELAXED, __HIP_MEMORY_SCOPE_AGENT); }
__device__ __forceinline__ float ld_wt(const float* p) { return __hip_atomic_load((GAS float*)p, __ATOMIC_RELAXED, __HIP_MEMORY_SCOPE_AGENT); }
struct EpiIn {
    static constexpr bool PERM = true, AFTER_DRAIN = false;
    bf16* Z; const float* SS; const float* bias; float* out; const f32x4* cs64; const f32x4* cs32; int layer;
    __device__ __forceinline__ void operator()(const f32x4 (&acc)[2][2][4][2], const pg8::Unit& u, int wr, int wc, int fr_, int fq_) const {
        int fr = fr_, fq = fq_; asm volatile("" : "+v"(fr), "+v"(fq));
        const int g = grp_of_tile(u.pm), row0 = u.pm * 256 + wr * 64 + fr, ct0 = wc * 32 + 8 * fq, col0 = u.pn * 256 + ct0;
        const float* bp = bias + g * DIN + col0;
        f32x4 bv[2][2];
#pragma unroll
        for (int bj = 0; bj < 2; ++bj)
#pragma unroll
            for (int n = 0; n < 2; ++n) bv[bj][n] = *(const f32x4*)(bp + bj * 128 + 4 * n);
        const bool cache = (u.pm < 16) && (u.pn == 7 || u.pn == 9 || u.pn == 10);
        int rk[2] = {0, 0};
        if (u.pm >= 16) { if (u.pn == 6) { rk[0] = 64; rk[1] = 64; } else if (u.pn == 7) { rk[0] = 64; } else if (u.pn == 8 || u.pn == 9) { rk[0] = 32; rk[1] = 32; } }
#pragma unroll
        for (int ai = 0; ai < 2; ++ai)
#pragma unroll
            for (int m = 0; m < 4; ++m) {
                const int row = row0 + ai * 128 + m * 16; const float rs = rstd_of4(SS, row, fq);
#pragma unroll
                for (int bj = 0; bj < 2; ++bj) {
                    f32x4 v0 = acc[ai][bj][m][0] * rs + bv[bj][0], v1 = acc[ai][bj][m][1] * rs + bv[bj][1];
                    const int ct = ct0 + bj * 128;
                    if (rk[bj]) {
                        const int t = (row - NCTX) & 1023; f32x4 c01, c23;
                        if (rk[bj] == 64) { const float* tf = (const float*)cs64 + (size_t)t * 64 + (ct & 63); c01 = *(const f32x4*)tf; c23 = *(const f32x4*)(tf + 4); }
                        else { const float* tf = (const float*)cs32 + (size_t)t * 32 + (ct & 31); c01 = *(const f32x4*)tf; c23 = *(const f32x4*)(tf + 4); }
                        const float a0 = v0[0], b0 = v0[1], a1 = v0[2], b1 = v0[3], a2 = v1[0], b2 = v1[1], a3 = v1[2], b3 = v1[3];
                        v0[0] = a0 * c01[0] - b0 * c01[1]; v0[1] = a0 * c01[1] + b0 * c01[0]; v0[2] = a1 * c01[2] - b1 * c01[3]; v0[3] = a1 * c01[3] + b1 * c01[2];
                        v1[0] = a2 * c23[0] - b2 * c23[1]; v1[1] = a2 * c23[1] + b2 * c23[0]; v1[2] = a3 * c23[2] - b3 * c23[3]; v1[3] = a3 * c23[3] + b3 * c23[2];
                    }
                    u32x4 w; w.x = pk2(v0[0], v0[1]); w.y = pk2(v0[2], v0[3]); w.z = pk2(v1[0], v1[1]); w.w = pk2(v1[2], v1[3]);
                    *(u32x4*)(Z + (size_t)row * DIN + col0 + bj * 128) = w;
                    if (cache) {
                        const int b = u.pm, t = row - b * 256;
                        if (u.pn == 7 && bj == 0) {
                            float* dst = out + O_SWAK + ((size_t)(b * 4 + layer) * 256 + t) * 128 + (ct & ~63) + ((ct & 63) >> 1);
                            *(f32x4*)dst = (f32x4){v0[0], v0[2], v1[0], v1[2]}; *(f32x4*)(dst + 32) = (f32x4){v0[1], v0[3], v1[1], v1[3]};
                        } else if (u.pn == 9) {
                            float* dst = out + O_DK + ((size_t)(b * 4 + layer) * 256 + t) * 256 + (ct & ~31) + ((ct & 31) >> 1);
                            *(f32x4*)dst = (f32x4){v0[0], v0[2], v1[0], v1[2]}; *(f32x4*)(dst + 16) = (f32x4){v0[1], v0[3], v1[1], v1[3]};
                        } else {
                            float* dst = u.pn == 7 ? out + O_SWAV + ((size_t)(b * 4 + layer) * 256 + t) * 128 + ct - 128 : out + O_DV + ((size_t)(b * 4 + layer) * 256 + t) * 256 + ct;
                            *(f32x4*)dst = v0; *(f32x4*)(dst + 4) = v1;
                        }
                    }
                }
            }
    }
};
struct EpiRes {
    static constexpr bool PERM = true, AFTER_DRAIN = false;
    bf16* X; bf16* XB; float* SS; const float* gate; const float* gm;
    __device__ __forceinline__ void operator()(const f32x4 (&acc)[2][2][4][2], const pg8::Unit& u, int wr, int wc, int fr_, int fq_) const {
        int fr = fr_, fq = fq_; asm volatile("" : "+v"(fr), "+v"(fq));
        const int g = grp_of_tile(u.pm), row0 = u.pm * 256 + wr * 64 + fr, col0 = u.pn * 256 + wc * 32 + 8 * fq;
        f32x4 gv[2][2], mv[2][2];
#pragma unroll
        for (int bj = 0; bj < 2; ++bj)
#pragma unroll
            for (int n = 0; n < 2; ++n) { gv[bj][n] = *(const f32x4*)(gate + (size_t)g * NMOD + col0 + bj * 128 + 4 * n);
                mv[bj][n] = gm ? *(const f32x4*)(gm + (size_t)g * DM + col0 + bj * 128 + 4 * n) : (f32x4){0.f, 0.f, 0.f, 0.f}; }
#pragma unroll
        for (int ai = 0; ai < 2; ++ai) {
            u32x4 xr[4][2];
#pragma unroll
            for (int m = 0; m < 4; ++m)
#pragma unroll
                for (int bj = 0; bj < 2; ++bj) xr[m][bj] = *(const u32x4*)(X + (size_t)(row0 + ai * 128 + m * 16) * DM + col0 + bj * 128);
#pragma unroll
            for (int m = 0; m < 4; ++m) {
                const int row = row0 + ai * 128 + m * 16; float ss = 0.f;
#pragma unroll
                for (int bj = 0; bj < 2; ++bj) {
                    float xf[8]; unpack8(xr[m][bj], xf);
                    const f32x4 x0 = (f32x4){xf[0], xf[1], xf[2], xf[3]} + gv[bj][0] * acc[ai][bj][m][0], x1 = (f32x4){xf[4], xf[5], xf[6], xf[7]} + gv[bj][1] * acc[ai][bj][m][1];
                    u32x4 wx; wx.x = pk2(x0[0], x0[1]); wx.y = pk2(x0[2], x0[3]); wx.z = pk2(x1[0], x1[1]); wx.w = pk2(x1[2], x1[3]);
                    *(u32x4*)(X + (size_t)row * DM + col0 + bj * 128) = wx;
                    ss += (x0[0] * x0[0] + x0[1] * x0[1]) + (x0[2] * x0[2] + x0[3] * x0[3]) + (x1[0] * x1[0] + x1[1] * x1[1]) + (x1[2] * x1[2] + x1[3] * x1[3]);
                    if (gm) { const f32x4 y0 = x0 * mv[bj][0], y1 = x1 * mv[bj][1];
                        u32x4 w; w.x = pk2(y0[0], y0[1]); w.y = pk2(y0[2], y0[3]); w.z = pk2(y1[0], y1[1]); w.w = pk2(y1[2], y1[3]);
                        *(u32x4*)(XB + (size_t)row * DM + col0 + bj * 128) = w; }
                }
                ss = sum_x16(ss); ss = sum_x32(ss);
                if (fq == 0) SS[(size_t)row * 16 + u.pn * 4 + wc] = ss;
            }
        }
    }
};
struct EpiFF1 {
    static constexpr bool PERM = true, AFTER_DRAIN = false;
    bf16* H; const float* SS; const float* bias;
    __device__ __forceinline__ void operator()(const f32x4 (&acc)[2][2][4][2], const pg8::Unit& u, int wr, int wc, int fr_, int fq_) const {
        int fr = fr_, fq = fq_; asm volatile("" : "+v"(fr), "+v"(fq));
        const int g = grp_of_tile(u.pm), row0 = u.pm * 256 + wr * 64 + fr, col0 = u.pn * 256 + wc * 32 + 8 * fq;
        const float* bp = bias + g * DFF + col0;
        f32x4 bv[2][2];
#pragma unroll
        for (int bj = 0; bj < 2; ++bj)
#pragma unroll
            for (int n = 0; n < 2; ++n) bv[bj][n] = *(const f32x4*)(bp + bj * 128 + 4 * n);
#pragma unroll
        for (int ai = 0; ai < 2; ++ai)
#pragma unroll
            for (int m = 0; m < 4; ++m) {
                const int row = row0 + ai * 128 + m * 16; const float rs = rstd_of4(SS, row, fq);
#pragma unroll
                for (int bj = 0; bj < 2; ++bj) {
                    f32x4 v0 = acc[ai][bj][m][0] * rs + bv[bj][0], v1 = acc[ai][bj][m][1] * rs + bv[bj][1];
#pragma unroll
                    for (int e = 0; e < 4; ++e) { const float a = fmaxf(v0[e], 0.f), b = fmaxf(v1[e], 0.f); v0[e] = a * a; v1[e] = b * b; }
                    u32x4 w; w.x = pk2(v0[0], v0[1]); w.y = pk2(v0[2], v0[3]); w.z = pk2(v1[0], v1[1]); w.w = pk2(v1[2], v1[3]);
                    *(u32x4*)(H + (size_t)row * DFF + col0 + bj * 128) = w;
                }
            }
    }
};

struct InOrder {
    int G, c;
    __host__ __device__ static void decode(int w, int nM, int nN, int& pm, int& pn) {
        const int nwg = nM * nN, q = nwg / 8, r = nwg % 8, xcd = w % 8, off = w / 8; const int wg = (xcd < r ? xcd * (q + 1) : r * (q + 1) + (xcd - r) * q) + off;
        const int nig = 8 * nN, gid = wg / nig, fm = gid * 8, gsz = (nM - fm) < 8 ? (nM - fm) : 8; pm = fm + ((wg % nig) % gsz); pn = (wg % nig) / gsz;
    }
    __host__ __device__ bool next(int i, pg8::Unit& u) const {
        const long L = (long)i * G + c; if (L >= 512) return false;
        int pm, pn;
        if (L < 352) { decode((int)L, 32, 11, pm, pn); u.pm = 16 + pm; u.pn = pn; }
        else { decode((int)L - 352, 16, 10, pm, pn); u.pm = pm; u.pn = pn >= 8 ? pn + 1 : pn; }
        return true;
    }
    __device__ __forceinline__ void a_ready(const pg8::Unit&) const {}
    __device__ __forceinline__ void done(const pg8::Unit&) const {}
};
struct OneUnit {
    int pm, pn;
    __host__ __device__ bool next(int i, pg8::Unit& u) const { if (i != 0) return false; u.pm = pm; u.pn = pn; return true; }
    __device__ __forceinline__ void a_ready(const pg8::Unit&) const {}
    __device__ __forceinline__ void done(const pg8::Unit&) const {}
};

template <bool PERMIN>
__device__ __forceinline__ void transpose_item(const float* W, int K, int N, bf16* WT, LAS float* scr, int item, int lane) {
    const int nblk = N / 32, kb = item / nblk, nb = item % nblk, k0 = 64 * kb, n0 = 32 * nb;
    float wv[32];
#pragma unroll
    for (int i = 0; i < 32; ++i) wv[i] = __builtin_nontemporal_load(&W[(size_t)(k0 + 2 * i + (lane >> 5)) * N + n0 + (lane & 31)]);
#pragma unroll
    for (int i = 0; i < 32; ++i) scr[(2 * i + (lane >> 5)) * 33 + (lane & 31)] = wv[i];
    asm volatile("s_waitcnt lgkmcnt(0)" ::: "memory");
    const int c = lane & 7;
#pragma unroll
    for (int j = 0; j < 4; ++j) { const int n = (lane >> 3) + 8 * j; const LAS float* s = scr + (8 * c) * 33 + n;
        u32x4 o; o.x = pk2(s[0 * 33], s[1 * 33]); o.y = pk2(s[2 * 33], s[3 * 33]); o.z = pk2(s[4 * 33], s[5 * 33]); o.w = pk2(s[6 * 33], s[7 * 33]);
        *(u32x4*)(WT + (size_t)(PERMIN ? perm_in(n0 + n) : n0 + n) * K + k0 + 8 * c) = o; }
    asm volatile("s_waitcnt lgkmcnt(0)" ::: "memory");
}
template <bool SILU, bool PERMOUT>
__device__ __forceinline__ void gemv_item(LAS unsigned char* lds, const float* W, int N, int n0, const float* v0, const float* v1, int vs, const float* bias, float* out, int ldo, const int wave_s__) {
    LAS float* vl = (LAS float*)lds;
    LAS float* red = (LAS float*)(lds + 36864);
    int tid_l = TIDX; asm volatile("" : "+v"(tid_l));
    const int tid = tid_l, lane = tid & 63, w = tid >> 6;
    __syncthreads();
    {   float vv[NG * 1024 / NT];
#pragma unroll
        for (int r = 0; r < NG * 1024 / NT; ++r) { const int i = tid + NT * r, g = i >> 10, k = i & 1023; vv[r] = (g == 0) ? v0[k] : v1[(size_t)(g - 1) * vs + k]; }
#pragma unroll
        for (int r = 0; r < NG * 1024 / NT; ++r) { float v = vv[r]; if (SILU) v = v * sigmoidf_(v); vl[tid + NT * r] = v; } }
    __syncthreads();
    float acc[NG];
#pragma unroll
    for (int g = 0; g < NG; ++g) acc[g] = 0.f;
    const float* wp = W + (size_t)(w * 128) * N + n0 + lane;
    for (int k8 = 0; k8 < 128; k8 += 32) {
        float wv[32];
#pragma unroll
        for (int j = 0; j < 32; ++j) wv[j] = __builtin_nontemporal_load(&wp[(size_t)(k8 + j) * N]);
#pragma unroll
        for (int j = 0; j < 32; ++j)
#pragma unroll
            for (int g = 0; g < NG; ++g) acc[g] += vl[g * 1024 + w * 128 + k8 + j] * wv[j];
    }
#pragma unroll
    for (int g = 0; g < NG; ++g) red[(w * NG + g) * 64 + lane] = acc[g];
    __syncthreads();
    for (int i = tid; i < NG * 64; i += NT) { const int g = i >> 6, ln = i & 63; float s = 0.f;
#pragma unroll
        for (int ww = 0; ww < 8; ++ww) s += red[(ww * NG + g) * 64 + ln];
        out[(size_t)g * ldo + (PERMOUT ? perm_in(n0 + ln) : n0 + ln)] = s + (bias ? bias[n0 + ln] : 0.f); }
}

__device__ __forceinline__ f32x4 mfma16(bf16x8 a, bf16x8 b, f32x4 c) { return __builtin_amdgcn_mfma_f32_16x16x32_bf16(a, b, c, 0, 0, 0); }
constexpr int KS_STRIDE = 72, VT_STRIDE = 72;
constexpr int LDS_KS = 0, LDS_VT = 128 * KS_STRIDE * 2;
__device__ __forceinline__ float asf(unsigned u) { return __builtin_bit_cast(float, u); }

__device__ __forceinline__ void store_vt(LAS bf16* VT, int key, int c8, const u32x4 raw) { *(LAS u32x4*)(VT + key * VT_STRIDE + 8 * c8) = raw; }
typedef short v4i16_t __attribute__((ext_vector_type(4)));
__device__ __forceinline__ v4i16_t vtr(LAS const bf16* p) { return __builtin_amdgcn_ds_read_tr16_b64_v4i16((LAS v4i16_t*)p); }
struct Pre { u32x4 r[4]; };
__device__ __forceinline__ void pf_z(Pre& p, const bf16* Z, int rowbase, int kcol, int vcol, int tid) {
#pragma unroll
    for (int r = 0; r < 2; ++r) { const int idx = tid + NT * r, key = idx >> 3, c8 = idx & 7; const bf16* q = Z + (size_t)(rowbase + key) * DIN + 8 * c8;
        p.r[2 * r] = *(const u32x4*)(q + kcol); p.r[2 * r + 1] = *(const u32x4*)(q + vcol); }
}
__device__ __forceinline__ void st_z(const Pre& p, LAS bf16* Ks, LAS bf16* VT, int tid) {
#pragma unroll
    for (int r = 0; r < 2; ++r) { const int idx = tid + NT * r, key = idx >> 3, c8 = idx & 7; *(LAS u32x4*)(Ks + key * KS_STRIDE + 8 * c8) = p.r[2 * r]; store_vt(VT, key, c8, p.r[2 * r + 1]); }
}
template <int HD>
__device__ __forceinline__ void pf_cache(Pre& p, const float* CK, const float* CV, int rs, int tid) {
    const int key = tid >> 3, c8 = tid & 7, sub = HD == 64 ? 0 : (c8 >> 2) * 32, i0 = HD == 64 ? 4 * c8 : 4 * (c8 & 3);
    const float* kp = CK + (size_t)key * rs + sub + i0; const float* vp = CV + (size_t)key * rs + 8 * c8;
    p.r[0] = *(const u32x4*)kp; p.r[1] = *(const u32x4*)(kp + HD / 2); p.r[2] = *(const u32x4*)vp; p.r[3] = *(const u32x4*)(vp + 4);
}
__device__ __forceinline__ u32x4 pack_f32x8(const u32x4 a, const u32x4 b) { u32x4 w; w.x = pk2(asf(a.x), asf(a.y)); w.y = pk2(asf(a.z), asf(a.w)); w.z = pk2(asf(b.x), asf(b.y)); w.w = pk2(asf(b.z), asf(b.w)); return w; }
__device__ __forceinline__ void st_cache(const Pre& p, LAS bf16* Ks, LAS bf16* VT, int tid) {
    const int key = tid >> 3, c8 = tid & 7; const u32x4 e = p.r[0], o = p.r[1];
    u32x4 w; w.x = pk2(asf(e.x), asf(o.x)); w.y = pk2(asf(e.y), asf(o.y)); w.z = pk2(asf(e.z), asf(o.z)); w.w = pk2(asf(e.w), asf(o.w));
    *(LAS u32x4*)(Ks + key * KS_STRIDE + 8 * c8) = w; store_vt(VT, key, c8, pack_f32x8(p.r[2], p.r[3]));
}
__device__ __forceinline__ void pf_state(Pre& p, const float* S0, int tid) { const float* vp = S0 + (size_t)(tid >> 3) * 64 + 8 * (tid & 7); p.r[2] = *(const u32x4*)vp; p.r[3] = *(const u32x4*)(vp + 4); }
__device__ __forceinline__ void st_state(const Pre& p, LAS bf16* Ks, LAS bf16* VT, int tid) {
    const int key = tid >> 3, c8 = tid & 7; u32x4 r = {0u, 0u, 0u, 0u};
    if ((key >> 3) == c8) { const unsigned one = 0x3F80u << (16 * (key & 1)); const int wd = (key & 7) >> 1; r.x = wd == 0 ? one : 0u; r.y = wd == 1 ? one : 0u; r.z = wd == 2 ? one : 0u; r.w = wd == 3 ? one : 0u; }
    *(LAS u32x4*)(Ks + key * KS_STRIDE + 8 * c8) = r; store_vt(VT, key, c8, pack_f32x8(p.r[2], p.r[3]));
}

constexpr int LDS_SLOT = 2 * 128 * KS_STRIDE * 2, LDS_TAB = 2 * LDS_SLOT;
template <int NV>
__device__ __forceinline__ void softmax_step(float (&p)[NV], float& m, float& l, f32x4 (&o)[4], bool force) {
    bool big = force;
#pragma unroll
    for (int j = 0; j < NV; ++j) big |= p[j] > 8.f;
    if (__builtin_amdgcn_ballot_w64(big) != 0ull) {
        float mx = p[0];
#pragma unroll
        for (int j = 1; j < NV; ++j) mx = fmaxf(mx, p[j]);
        mx = max_x16(mx); mx = max_x32(mx);
        const bool mv = force || mx > 8.f;
        const float d = mv ? mx : 0.f, al = ex2(-d); m += d; l *= al;
#pragma unroll
        for (int j = 0; j < NV; ++j) p[j] -= d;
#pragma unroll
        for (int n = 0; n < 4; ++n) o[n] = o[n] * al;
    }
    float sum = 0.f;
#pragma unroll
    for (int j = 0; j < NV; ++j) { p[j] = ex2(p[j]); sum += p[j]; }
    l += sum;
}
template <int MODE, int KS>
__device__ __forceinline__ void attn_compute(LAS const bf16* Ks, LAS const bf16* VT, int nk, int kind, int kp0, int qpos, const bf16x8 (&qf)[2],
                                             f32x4 (&o)[4], f32x4 (&o2)[4], float& m1, float& l1, float& m2, float& l2, float c1, float lgf2, float lgb2, int g, int lq, bool first, LAS const float* tab) {
    constexpr int NTL = KS / 16, NV = KS / 4, NH = KS / 32;
    const f32x4 zero = {0.f, 0.f, 0.f, 0.f};
    float Af = 0.f, Ab = 0.f;
    if (MODE == 0 && kind == 2) { Af = ex2(lgf2 * (float)(qpos - kp0)); Ab = ex2(lgb2 * (float)(kp0 - qpos)); }
    for (int kk = 0; kk < nk / KS; ++kk) {
        f32x4 s[NTL], t[NTL];
        const f32x4 nm1 = {-m1, -m1, -m1, -m1}, nm2 = {-m2, -m2, -m2, -m2};
#pragma unroll
        for (int tt = 0; tt < NTL; ++tt) {
            LAS const bf16* kr = Ks + (kk * KS + tt * 16 + lq) * KS_STRIDE + 8 * g;
            const bf16x8 k0 = *(LAS const bf16x8*)kr, k1 = *(LAS const bf16x8*)(kr + 32);
            if (MODE == 2) { s[tt] = mfma16(k0, qf[0], nm1); t[tt] = mfma16(k1, qf[1], nm2); }
            else { s[tt] = mfma16(k0, qf[0], MODE == 1 ? nm1 : zero); s[tt] = mfma16(k1, qf[1], s[tt]); t[tt] = zero; }
        }
        float p[NV], p2[NV];
        if (MODE == 0) {
            if (kind == 2) {
                const int qlo = __builtin_amdgcn_readfirstlane(qpos - lq), klo = kp0 + kk * KS;
                if (klo + KS - 1 < qlo) {
#pragma unroll
                    for (int tt = 0; tt < NTL; ++tt) { const f32x4 cf = *(LAS const f32x4*)(tab + kk * KS + tt * 16 + 4 * g);
#pragma unroll
                        for (int i = 0; i < 4; ++i) p[tt * 4 + i] = s[tt][i] * (Af * cf[i]); }
                } else if (klo > qlo + 15) {
#pragma unroll
                    for (int tt = 0; tt < NTL; ++tt) { const f32x4 cb = *(LAS const f32x4*)(tab + 128 + kk * KS + tt * 16 + 4 * g);
#pragma unroll
                        for (int i = 0; i < 4; ++i) p[tt * 4 + i] = s[tt][i] * (Ab * cb[i]); }
                } else {
#pragma unroll
                    for (int tt = 0; tt < NTL; ++tt) { const int j0 = kk * KS + tt * 16 + 4 * g; const f32x4 cf = *(LAS const f32x4*)(tab + j0), cb = *(LAS const f32x4*)(tab + 128 + j0);
#pragma unroll
                        for (int i = 0; i < 4; ++i) { const int d = qpos - kp0 - j0 - i; const float f = d > 0 ? Af * cf[i] : (d < 0 ? Ab * cb[i] : 0.25f); p[tt * 4 + i] = s[tt][i] * f; } }
                }
            } else {
#pragma unroll
                for (int tt = 0; tt < NTL; ++tt)
#pragma unroll
                    for (int i = 0; i < 4; ++i) p[tt * 4 + i] = s[tt][i] * c1;
            }
        } else {
            bool masked = false;
            if (MODE == 1 && kind == 1) { const int qlo = __builtin_amdgcn_readfirstlane(qpos - lq), klo = kp0 + kk * KS; masked = (qlo + 15 - klo > 128) || (klo + KS - 1 - qlo > 128); }
#pragma unroll
            for (int tt = 0; tt < NTL; ++tt)
#pragma unroll
                for (int i = 0; i < 4; ++i) {
                    float v = s[tt][i];
                    if (MODE == 1 && masked) { const int d = qpos - (kp0 + kk * KS + tt * 16 + 4 * g + i); if (d > 128 || d < -128) v = -INFINITY; }
                    p[tt * 4 + i] = v;
                }
            softmax_step<NV>(p, m1, l1, o, MODE == 2 && first && kk == 0);
            if (MODE == 2) {
#pragma unroll
                for (int tt = 0; tt < NTL; ++tt)
#pragma unroll
                    for (int i = 0; i < 4; ++i) p2[tt * 4 + i] = t[tt][i];
                softmax_step<NV>(p2, m2, l2, o2, first && kk == 0);
            }
        }
        bf16x8 pf[NH], pf2[NH];
#pragma unroll
        for (int hh = 0; hh < NH; ++hh) {
            u32x4 w; w.x = pk2(p[8 * hh], p[8 * hh + 1]); w.y = pk2(p[8 * hh + 2], p[8 * hh + 3]); w.z = pk2(p[8 * hh + 4], p[8 * hh + 5]); w.w = pk2(p[8 * hh + 6], p[8 * hh + 7]);
            pf[hh] = __builtin_bit_cast(bf16x8, w); pf2[hh] = pf[hh];
            if (MODE == 2) { u32x4 w2; w2.x = pk2(p2[8 * hh], p2[8 * hh + 1]); w2.y = pk2(p2[8 * hh + 2], p2[8 * hh + 3]); w2.z = pk2(p2[8 * hh + 4], p2[8 * hh + 5]); w2.w = pk2(p2[8 * hh + 6], p2[8 * hh + 7]);
                pf2[hh] = __builtin_bit_cast(bf16x8, w2); }
        }
#pragma unroll
        for (int hh = 0; hh < NH; ++hh)
#pragma unroll
            for (int n = 0; n < 4; ++n) {
                LAS const bf16* vr = VT + (kk * KS + hh * 32 + 4 * g + (lq >> 2)) * VT_STRIDE + 16 * n + 4 * (lq & 3);
                const v4i16_t lo = vtr(vr), hi = vtr(vr + 16 * VT_STRIDE);
                const bf16x8 vf = {lo[0], lo[1], lo[2], lo[3], hi[0], hi[1], hi[2], hi[3]};
                o[n] = mfma16(vf, pf[hh], o[n]);
                if (MODE == 2) o2[n] = mfma16(vf, pf2[hh], o2[n]);
            }
    }
}

template <int MODE>
__device__ __forceinline__ void attn_unit(const Args& a, LAS unsigned char* lds, int layer, int seq, int h, int qb, const int wave_s__) {
    int tid_l = TIDX; asm volatile("" : "+v"(tid_l));
    const int tid = tid_l, lane = tid & 63, w = tid >> 6, g = lane >> 4, lq = lane & 15;
    const bool lat = seq >= 16; const int b = lat ? seq - 16 : seq, L = lat ? 1024 : 256, row0 = lat ? NCTX + b * 1024 : b * 256;
    const bf16* Z = (const bf16*)(a.ws + WS_Z); bf16* Y = (bf16*)(a.ws + WS_Y);
    LAS bf16* Ks = (LAS bf16*)(lds + LDS_KS); LAS bf16* VT = (LAS bf16*)(lds + LDS_VT);
    const int q0 = qb * 128, qpos = q0 + w * 16 + lq;
    const int kvh = MODE == 1 ? (h >> 1) : h;
    const int qcol = (MODE == 0 ? 0 : MODE == 1 ? 1536 : 2048) + h * 64, kcol = (MODE == 0 ? 256 : MODE == 1 ? 1792 : 2304) + kvh * 64, vcol = (MODE == 0 ? 512 : MODE == 1 ? 1920 : 2560) + kvh * 64;
    float m1 = 0.f, l1 = 0.f, m2 = 0.f, l2 = 0.f, c1 = 0.f, lgf2 = 0.f, lgb2 = 0.f;
    float xdf = 0.f, xdb = 0.f;
    if (MODE == 0) { xdf = a.in[I_RDEC][(layer * 2 + 0) * 4 + h]; xdb = a.in[I_RDEC][(layer * 2 + 1) * 4 + h]; }
    else if (MODE == 1) { c1 = 0.125f * LOG2E; m1 = a.in[I_SINK][layer * 4 + h] * LOG2E; l1 = (g == 0) ? 1.f : 0.f; }
    else { c1 = 0.17677669529663687f * LOG2E; }
    bf16x8 qf[2];
    { const bf16* qp = Z + (size_t)(row0 + qpos) * DIN + qcol;
#pragma unroll
      for (int ks = 0; ks < 2; ++ks) {
          u32x4 raw = *(const u32x4*)(qp + 32 * ks + 8 * g);
          if (MODE != 0) { float x[8]; unpack8(raw, x);
#pragma unroll
              for (int j = 0; j < 8; ++j) x[j] *= c1;
              raw = pack8(x); }
          qf[ks] = __builtin_bit_cast(bf16x8, raw);
      } }
    float lpa = 0.f, lpb = 0.f;
    if (MODE == 2 && lane < 32) { const float* lv = a.in[I_DLAM] + layer * 128; lpa = lv[lane] * lv[32 + lane]; lpb = lv[64 + lane] * lv[96 + lane]; }
    f32x4 o[4], o2[4];
#pragma unroll
    for (int n = 0; n < 4; ++n) { o[n] = (f32x4){0.f, 0.f, 0.f, 0.f}; o2[n] = (f32x4){0.f, 0.f, 0.f, 0.f}; }
    int ka0 = 0, ka1 = L;
    if (MODE == 1 && lat) { ka0 = q0 - 128 < 0 ? 0 : q0 - 128; ka1 = q0 + 256 > L ? L : q0 + 256; }
    const int kindA = MODE == 0 ? 2 : (MODE == 1 && lat) ? 1 : 0;
    const int nzc = (ka1 - ka0) >> 7, ntot = nzc + (lat ? (MODE == 0 ? 2 : 4) : 0);
    const float* CK = a.in[MODE == 1 ? I_CSK : I_CDK]; const float* CV = a.in[MODE == 1 ? I_CSV : I_CDV];
    const int rs = MODE == 1 ? 128 : 256; const size_t cbase = (size_t)(b * 4 + layer) * 256 * rs + kvh * 64;
    const float* S0 = a.in[I_SRET] + ((size_t)((b * 4 + layer) * 2) * 4 + h) * 4096;
    LAS const float* tab = (LAS const float*)(lds + LDS_TAB);
    LAS bf16* K0 = (LAS bf16*)lds; LAS bf16* V0 = K0 + 128 * KS_STRIDE; LAS bf16* K1 = (LAS bf16*)(lds + LDS_SLOT); LAS bf16* V1 = K1 + 128 * KS_STRIDE;
#define ATT_PF(P, cn) do { if ((cn) < ntot) { \
        if ((cn) < nzc) pf_z(P, Z, row0 + ka0 + 128 * (cn), kcol, vcol, tid); \
        else if (MODE == 0) pf_state(P, S0 + (size_t)((cn) - nzc) * 4 * 4096, tid); \
        else pf_cache<MODE == 1 ? 64 : 32>(P, CK + cbase + (size_t)((cn) - nzc) * 64 * rs, CV + cbase + (size_t)((cn) - nzc) * 64 * rs, rs, tid); } } while (0)
#define ATT_ST(P, c, KS_, VS_) do { if ((c) < nzc) st_z(P, KS_, VS_, tid); else if (MODE == 0) st_state(P, KS_, VS_, tid); else st_cache(P, KS_, VS_, tid); } while (0)
#define ATT_CMP(c, KS_, VS_) do { \
        if ((c) < nzc) attn_compute<MODE, (MODE == 2 ? 64 : 128)>(KS_, VS_, 128, kindA, ka0 + 128 * (c), qpos, qf, o, o2, m1, l1, m2, l2, c1, lgf2, lgb2, g, lq, (c) == 0, tab); \
        else if (MODE == 0) { const float rf = ((c) == nzc) ? ex2(lgf2 * (float)(qpos + 1)) : ex2(lgb2 * (float)(L - qpos)); \
            attn_compute<MODE, 64>(KS_, VS_, 64, 3, 0, qpos, qf, o, o2, m1, l1, m2, l2, rf, lgf2, lgb2, g, lq, false, tab); } \
        else attn_compute<MODE, 64>(KS_, VS_, 64, 0, 0, qpos, qf, o, o2, m1, l1, m2, l2, c1, lgf2, lgb2, g, lq, false, tab); } while (0)
    Pre preA, preB;
    ATT_PF(preA, 0); ATT_PF(preB, 1);
    if (MODE == 0) { lgf2 = -log1pf(__expf(-xdf)) * LOG2E; lgb2 = -log1pf(__expf(-xdb)) * LOG2E; }
    __syncthreads();
    if (MODE == 0 && tid < 256) ((LAS float*)(lds + LDS_TAB))[tid] = 0.125f * (tid < 128 ? ex2(-lgf2 * (float)tid) : ex2(lgb2 * (float)(tid - 128)));
    ATT_ST(preA, 0, K0, V0); ATT_PF(preA, 2);
    __syncthreads();
#pragma unroll 1
    for (int c = 0; c < ntot; c += 2) {
        if (c + 1 < ntot) { ATT_ST(preB, c + 1, K1, V1); ATT_PF(preB, c + 3); }
        ATT_CMP(c, K0, V0);
        __syncthreads();
        if (c + 1 < ntot) {
            if (c + 2 < ntot) { ATT_ST(preA, c + 2, K0, V0); ATT_PF(preA, c + 4); }
            ATT_CMP(c + 1, K1, V1);
            __syncthreads();
        }
    }
#undef ATT_PF
#undef ATT_ST
#undef ATT_CMP
    const size_t row = (size_t)(row0 + qpos);
    if (MODE == 0) {
        float s = 0.f;
#pragma unroll
        for (int n = 0; n < 4; ++n) s += (o[n][0] + o[n][1]) + (o[n][2] + o[n][3]);
        s = sum_x16(s); s = sum_x32(s);
        const float mu = s * (1.f / 64.f); float q = 0.f;
#pragma unroll
        for (int n = 0; n < 4; ++n)
#pragma unroll
            for (int i = 0; i < 4; ++i) { const float d = o[n][i] - mu; q += d * d; }
        q = sum_x16(q); q = sum_x32(q);
        const float rs = rsqrtf(q * (1.f / 64.f) + EPS);
        f32x4 gnv[4]; u32x2 gzv[4];
#pragma unroll
        for (int n = 0; n < 4; ++n) { const int dv = 16 * n + 4 * g; gnv[n] = *(const f32x4*)(a.in[I_RGN] + layer * 256 + h * 64 + dv); gzv[n] = *(const u32x2*)(Z + row * DIN + 768 + h * 64 + dv); }
#pragma unroll
        for (int n = 0; n < 4; ++n) {
            const int dv = 16 * n + 4 * g; const f32x4 gn = gnv[n];
            const u32x2 gz = gzv[n];
            const float z0 = bflo(gz.x), z1 = bfhi(gz.x), z2 = bflo(gz.y), z3 = bfhi(gz.y);
            const float y0 = (o[n][0] - mu) * rs * gn[0] * (z0 * sigmoidf_(z0)), y1 = (o[n][1] - mu) * rs * gn[1] * (z1 * sigmoidf_(z1));
            const float y2 = (o[n][2] - mu) * rs * gn[2] * (z2 * sigmoidf_(z2)), y3 = (o[n][3] - mu) * rs * gn[3] * (z3 * sigmoidf_(z3));
            u32x2 wv; wv.x = pk2(y0, y1); wv.y = pk2(y2, y3);
            *(u32x2*)(Y + row * DM + h * 64 + dv) = wv;
        }
    } else if (MODE == 1) {
        float lt = l1; lt = sum_x16(lt); lt = sum_x32(lt);
        const float inv = rcp_(lt);
#pragma unroll
        for (int n = 0; n < 4; ++n) { u32x2 wv; wv.x = pk2(o[n][0] * inv, o[n][1] * inv); wv.y = pk2(o[n][2] * inv, o[n][3] * inv);
            *(u32x2*)(Y + row * DM + 512 + h * 64 + 16 * n + 4 * g) = wv; }
    } else {
        float lt1 = l1; lt1 = sum_x16(lt1); lt1 = sum_x32(lt1);
        float lt2 = l2; lt2 = sum_x16(lt2); lt2 = sum_x32(lt2);
        float pa = wave_sum(lpa), pb = wave_sum(lpb);
        const float linit = 0.8f - 0.6f * __expf(-0.3f * (float)layer), lam = __expf(pa) - __expf(pb) + linit;
        const float i1 = rcp_(lt1), i2 = lam * rcp_(lt2); float q = 0.f;
#pragma unroll
        for (int n = 0; n < 4; ++n)
#pragma unroll
            for (int i = 0; i < 4; ++i) { const float v = o[n][i] * i1 - o2[n][i] * i2; o[n][i] = v; q += v * v; }
        q = sum_x16(q); q = sum_x32(q);
        const float rs = rsqrtf(q * (1.f / 64.f) + EPS) * (1.f - linit);
        f32x4 dgn[4];
#pragma unroll
        for (int n = 0; n < 4; ++n) dgn[n] = *(const f32x4*)(a.in[I_DNG] + layer * 64 + 16 * n + 4 * g);
#pragma unroll
        for (int n = 0; n < 4; ++n) { const int dv = 16 * n + 4 * g; const f32x4 gn = dgn[n];
            u32x2 wv; wv.x = pk2(o[n][0] * rs * gn[0], o[n][1] * rs * gn[1]); wv.y = pk2(o[n][2] * rs * gn[2], o[n][3] * rs * gn[3]);
            *(u32x2*)(Y + row * DM + 768 + h * 64 + dv) = wv; }
    }
}

__device__ __forceinline__ void ret_state_unit(const Args& a, LAS unsigned char* lds, int layer, int b, int h, const int wave_s__) {
    int tid_l = TIDX; asm volatile("" : "+v"(tid_l));
    const int tid = tid_l; const bf16* Z = (const bf16*)(a.ws + WS_Z);
    LAS bf16* Kl = (LAS bf16*)lds; LAS bf16* Vl = (LAS bf16*)(lds + 32768); LAS float* WF = (LAS float*)(lds + 65536); LAS float* WB = (LAS float*)(lds + 66560);
    const float xf = a.in[I_RDEC][(layer * 2 + 0) * 4 + h], xb = a.in[I_RDEC][(layer * 2 + 1) * 4 + h];
    const float lgf2 = -log1pf(__expf(-xf)) * LOG2E, lgb2 = -log1pf(__expf(-xb)) * LOG2E;
    __syncthreads();
    for (int idx = tid; idx < 256 * 8; idx += NT) { const int key = idx >> 3, c8 = idx & 7; const bf16* p = Z + (size_t)(b * 256 + key) * DIN + h * 64 + 8 * c8;
        *(LAS u32x4*)(Kl + key * 64 + 8 * c8) = *(const u32x4*)(p + 256); *(LAS u32x4*)(Vl + key * 64 + 8 * c8) = *(const u32x4*)(p + 512); }
    if (tid < 256) { WF[tid] = 0.125f * ex2(lgf2 * (float)(255 - tid)); WB[tid] = 0.125f * ex2(lgb2 * (float)tid); }
    __syncthreads();
    const int dk = tid >> 3, dv0 = (tid & 7) * 8;
    float af[8], ab[8];
#pragma unroll
    for (int i = 0; i < 8; ++i) { af[i] = 0.f; ab[i] = 0.f; }
    for (int s = 0; s < 256; ++s) {
        const float kv = bf2f(Kl[s * 64 + dk]), kf = kv * WF[s], kb = kv * WB[s];
        float v[8]; unpack8(*(LAS const u32x4*)(Vl + s * 64 + dv0), v);
#pragma unroll
        for (int i = 0; i < 8; ++i) { af[i] += kf * v[i]; ab[i] += kb * v[i]; }
    }
    float* of = a.out + O_SRET + ((size_t)((b * 4 + layer) * 2 + 0) * 4 + h) * 4096 + dk * 64 + dv0;
    float* ob = a.out + O_SRET + ((size_t)((b * 4 + layer) * 2 + 1) * 4 + h) * 4096 + dk * 64 + dv0;
    *(f32x4*)of = (f32x4){af[0], af[1], af[2], af[3]}; *(f32x4*)(of + 4) = (f32x4){af[4], af[5], af[6], af[7]};
    *(f32x4*)ob = (f32x4){ab[0], ab[1], ab[2], ab[3]}; *(f32x4*)(ob + 4) = (f32x4){ab[4], ab[5], ab[6], ab[7]};
}

__device__ __forceinline__ void publish_count(unsigned* cnt, bool leader) {
    asm volatile("s_waitcnt vmcnt(0)" ::: "memory"); __syncthreads();
    if (leader) __hip_atomic_fetch_add((GAS unsigned*)cnt, 1u, __ATOMIC_RELAXED, __HIP_MEMORY_SCOPE_AGENT);
}
__device__ __forceinline__ void wait_count(unsigned* cnt, unsigned target, bool leader) {
    if (leader) { unsigned sp = 0; while (__hip_atomic_load((GAS unsigned*)cnt, __ATOMIC_RELAXED, __HIP_MEMORY_SCOPE_AGENT) < target && ++sp < (1u << 22)) __builtin_amdgcn_s_sleep(2);
        __builtin_amdgcn_fence(__ATOMIC_ACQUIRE, "agent"); asm volatile("s_waitcnt vmcnt(0)" ::: "memory"); }
    __syncthreads();
}
constexpr int LA_XC = 0, LA_XCF = 18432, LA_WT = 51200, LA_WTOT = 88064, LA_CW = 96256;
__device__ __forceinline__ void lru_a_unit(const Args& a, LAS unsigned char* lds, int layer, int seq, int n, int ci, const int wave_s__) {
    int tid_l = TIDX; asm volatile("" : "+v"(tid_l));
    const int tid = tid_l, lane = tid & 63, w = tid >> 6, g = lane >> 4, lq = lane & 15;
    const bool lat = seq >= 16; const int b = lat ? seq - 16 : seq, L = lat ? 1024 : 256, row0 = lat ? NCTX + b * 1024 : b * 256, t0 = ci * 128;
    const bf16* Z = (const bf16*)(a.ws + WS_Z);
    LAS bf16* XC = (LAS bf16*)(lds + LA_XC); LAS float* XCF = (LAS float*)(lds + LA_XCF); LAS bf16* WT = (LAS bf16*)(lds + LA_WT);
    LAS f32x2* WTOT = (LAS f32x2*)(lds + LA_WTOT); LAS float* CW = (LAS float*)(lds + LA_CW);
    const int ct = tid >> 2, c16 = (tid & 3) * 16;
    u32x4 xr[4][2];
#pragma unroll
    for (int j = 0; j < 4; ++j) { const int tt = t0 + ct - 2 + j;
        if (tt >= 0 && tt < L) { const bf16* p = Z + (size_t)(row0 + tt) * DIN + 1024 + n * 64 + c16; xr[j][0] = *(const u32x4*)p; xr[j][1] = *(const u32x4*)(p + 8); }
        else { xr[j][0] = (u32x4){0u, 0u, 0u, 0u}; xr[j][1] = (u32x4){0u, 0u, 0u, 0u}; } }
    u32x4 wq[4];
#pragma unroll
    for (int m = 0; m < 4; ++m) wq[m] = *(const u32x4*)((const bf16*)(a.ws + WS_WLRU) + ((size_t)((layer * 2 + (m >> 1)) * 2 + (m & 1)) * 4 + n) * 4096 + tid * 8);
    float pba[2][4], pbx[2][4], plam[2][4];
#pragma unroll
    for (int dd = 0; dd < 2; ++dd)
#pragma unroll
        for (int nt = 0; nt < 4; ++nt) { const size_t pofs = (size_t)(layer * 2 + dd) * 256 + n * 64 + 16 * nt + lq; pba[dd][nt] = a.in[I_LBA][pofs]; pbx[dd][nt] = a.in[I_LBX][pofs]; plam[dd][nt] = a.in[I_LLAM][pofs]; }
    float cwv = 0.f; if (tid < 320) { const int j = tid >> 6, c = tid & 63; cwv = j < 4 ? a.in[I_LCW][(layer * 4 + j) * 256 + n * 64 + c] : a.in[I_LCB][layer * 256 + n * 64 + c]; }
    __syncthreads();
    if (tid < 320) CW[tid] = cwv;
#pragma unroll
    for (int m = 0; m < 4; ++m) *(LAS u32x4*)(WT + (m * 64 + (tid >> 3)) * 72 + (tid & 7) * 8) = wq[m];
    __syncthreads();
    {   float acc[16];
#pragma unroll
        for (int i = 0; i < 4; ++i) { const f32x4 cb = *(LAS const f32x4*)(CW + 256 + c16 + 4 * i); acc[4 * i] = cb[0]; acc[4 * i + 1] = cb[1]; acc[4 * i + 2] = cb[2]; acc[4 * i + 3] = cb[3]; }
#pragma unroll
        for (int j = 0; j < 4; ++j) { float x[16]; { float x0[8], x1[8]; unpack8(xr[j][0], x0); unpack8(xr[j][1], x1);
#pragma unroll
                for (int i = 0; i < 8; ++i) { x[i] = x0[i]; x[8 + i] = x1[i]; } }
#pragma unroll
            for (int i = 0; i < 4; ++i) { const f32x4 cw = *(LAS const f32x4*)(CW + j * 64 + c16 + 4 * i);
                acc[4 * i] += cw[0] * x[4 * i]; acc[4 * i + 1] += cw[1] * x[4 * i + 1]; acc[4 * i + 2] += cw[2] * x[4 * i + 2]; acc[4 * i + 3] += cw[3] * x[4 * i + 3]; } }
        u32x4 w0, w1; w0.x = pk2(acc[0], acc[1]); w0.y = pk2(acc[2], acc[3]); w0.z = pk2(acc[4], acc[5]); w0.w = pk2(acc[6], acc[7]);
        w1.x = pk2(acc[8], acc[9]); w1.y = pk2(acc[10], acc[11]); w1.z = pk2(acc[12], acc[13]); w1.w = pk2(acc[14], acc[15]);
        *(LAS u32x4*)(XC + ct * 72 + c16) = w0; *(LAS u32x4*)(XC + ct * 72 + c16 + 8) = w1;
#pragma unroll
        for (int i = 0; i < 4; ++i) *(LAS f32x4*)(XCF + ct * 64 + c16 + 4 * i) = (f32x4){acc[4 * i], acc[4 * i + 1], acc[4 * i + 2], acc[4 * i + 3]};
    }
    __syncthreads();
    LAS const bf16* xrow = XC + (16 * w + lq) * 72 + 8 * g;
    const bf16x8 x0 = *(LAS const bf16x8*)xrow, x1 = *(LAS const bf16x8*)(xrow + 32);
    float hf[4][4];
    float* HS = (float*)(a.ws + WS_HS); float* PF = (float*)(a.ws + WS_PF); float* PB = (float*)(a.ws + WS_PB);
    f32x2* TOT = (f32x2*)(a.ws + WS_TOT) + ((size_t)((seq * 4 + n) * 8 + ci) * 2) * 64;
#pragma unroll 1
    for (int dir = 0; dir < 2; ++dir) {
        float P[4][4], hh[4][4];
        float PT[4], HT[4];
#pragma unroll
        for (int nt = 0; nt < 4; ++nt) {
            const f32x4 zero = {0.f, 0.f, 0.f, 0.f};
            LAS const bf16* wa = WT + ((dir * 2 + 0) * 64 + 16 * nt + lq) * 72 + 8 * g; LAS const bf16* wx = WT + ((dir * 2 + 1) * 64 + 16 * nt + lq) * 72 + 8 * g;
            f32x4 Ga = mfma16(x0, *(LAS const bf16x8*)wa, zero); Ga = mfma16(x1, *(LAS const bf16x8*)(wa + 32), Ga);
            f32x4 Gx = mfma16(x0, *(LAS const bf16x8*)wx, zero); Gx = mfma16(x1, *(LAS const bf16x8*)(wx + 32), Gx);
            const float ba = dir == 0 ? pba[0][nt] : pba[1][nt], bx = dir == 0 ? pbx[0][nt] : pbx[1][nt], lmv = dir == 0 ? plam[0][nt] : plam[1][nt];
            const float sp8 = 8.f * 0.6931471805599453f * __log2f(1.f + __expf(-lmv));
            float av[4], uv[4];
#pragma unroll
            for (int i = 0; i < 4; ++i) { const int t = 16 * w + 4 * g + i;
                const float r = sigmoidf_(Ga[i] + ba), ig = sigmoidf_(Gx[i] + bx), la = -r * sp8; av[i] = __expf(la);
                const float x2 = 2.f * la;
                const float ser = -x2 * (1.f + x2 * (0.5f + x2 * (0.16666667f + x2 * (0.041666668f + x2 * (0.0083333338f + x2 * 0.0013888889f)))));
                const float om = x2 > -0.25f ? ser : 1.f - av[i] * av[i];
                uv[i] = __builtin_amdgcn_sqrtf(fmaxf(om, 0.f)) * ig * XCF[t * 64 + 16 * nt + lq]; }
            float pp = 1.f, h = 0.f;
#pragma unroll
            for (int i = 0; i < 4; ++i) { const int ii = dir == 0 ? i : 3 - i; h = av[ii] * h + uv[ii]; pp *= av[ii]; P[nt][ii] = pp; hh[nt][ii] = h; }
            PT[nt] = pp; HT[nt] = h;
        }
        const int rk = dir == 0 ? g : 3 - g;
        float Pe[4], He[4];
#pragma unroll
        for (int nt = 0; nt < 4; ++nt) {
#pragma unroll
            for (int k = 1; k <= 2; k <<= 1) { const int src = ((dir == 0 ? lane - 16 * k : lane + 16 * k) & 63) << 2;
                const float Pp = asf_((unsigned)__builtin_amdgcn_ds_bpermute(src, (int)asu_(PT[nt]))), hp = asf_((unsigned)__builtin_amdgcn_ds_bpermute(src, (int)asu_(HT[nt])));
                if (rk >= k) { HT[nt] = PT[nt] * hp + HT[nt]; PT[nt] = PT[nt] * Pp; } }
            const int src = ((dir == 0 ? lane - 16 : lane + 16) & 63) << 2;
            Pe[nt] = asf_((unsigned)__builtin_amdgcn_ds_bpermute(src, (int)asu_(PT[nt]))); He[nt] = asf_((unsigned)__builtin_amdgcn_ds_bpermute(src, (int)asu_(HT[nt])));
            if (rk == 0) { Pe[nt] = 1.f; He[nt] = 0.f; }
            if (rk == 3) WTOT[(w * 2 + dir) * 64 + 16 * nt + lq] = (f32x2){PT[nt], HT[nt]};
        }
        __syncthreads();
#pragma unroll
        for (int nt = 0; nt < 4; ++nt) {
            float Pw = 1.f, hw = 0.f;
#pragma unroll
            for (int k = 0; k < 8; ++k) { const int w2 = dir == 0 ? k : 7 - k; const bool before = dir == 0 ? (w2 < w) : (w2 > w);
                const f32x2 e = WTOT[(w2 * 2 + dir) * 64 + 16 * nt + lq]; if (before) { hw = e.x * hw + e.y; Pw = e.x * Pw; } }
            const float Pex = Pe[nt] * Pw, hex = Pe[nt] * hw + He[nt];
            const int ch = n * 64 + 16 * nt + lq;
#pragma unroll
            for (int i = 0; i < 4; ++i) { const size_t idx = (size_t)(row0 + t0 + 16 * w + 4 * g + i) * 256 + ch;
                const float hv = P[nt][i] * hex + hh[nt][i], pv = P[nt][i] * Pex;
                if (dir == 0) { hf[nt][i] = hv; st_wt(PF + idx, pv); } else { st_wt(HS + idx, hf[nt][i] + hv); st_wt(PB + idx, pv); }
                if (rk == 3 && w == (dir == 0 ? 7 : 0) && i == (dir == 0 ? 3 : 0)) { float* tp = (float*)(TOT + dir * 64 + 16 * nt + lq); st_wt(tp, pv); st_wt(tp + 1, hv); } }
        }
    }
    publish_count((unsigned*)(a.ws + WS_CTL) + CW_LRU + layer * 128 + seq * 4 + n, tid == 0);
}
__device__ __forceinline__ void lru_b_unit(const Args& a, LAS unsigned char* lds, int layer, int seq, int n, int ci, const int wave_s__) {
    int tid_l = TIDX; asm volatile("" : "+v"(tid_l));
    const int tid = tid_l;
    const bool lat = seq >= 16; const int b = lat ? seq - 16 : seq, L = lat ? 1024 : 256, row0 = lat ? NCTX + b * 1024 : b * 256, nc = L / 128;
    unsigned* cnt = (unsigned*)(a.ws + WS_CTL) + CW_LRU + layer * 128 + seq * 4 + n;
    wait_count(cnt, (unsigned)nc, tid == 0);
    const bf16* Z = (const bf16*)(a.ws + WS_Z); bf16* Y = (bf16*)(a.ws + WS_Y);
    const float* HS = (const float*)(a.ws + WS_HS); const float* PF = (const float*)(a.ws + WS_PF); const float* PB = (const float*)(a.ws + WS_PB);
    f32x4 hs[4], pf[4], pb[4]; u32x2 gz[4];
#pragma unroll
    for (int r = 0; r < 4; ++r) { const int idx = tid + NT * r, t = ci * 128 + (idx >> 4), c4 = (idx & 15) * 4; const size_t row = (size_t)(row0 + t);
        hs[r] = __builtin_nontemporal_load((const f32x4*)(HS + row * 256 + n * 64 + c4)); pf[r] = __builtin_nontemporal_load((const f32x4*)(PF + row * 256 + n * 64 + c4)); pb[r] = __builtin_nontemporal_load((const f32x4*)(PB + row * 256 + n * 64 + c4));
        gz[r] = *(const u32x2*)(Z + row * DIN + 1280 + n * 64 + c4); }
    LAS float* CF = (LAS float*)lds; LAS float* CB = CF + 64;
    const f32x2* TOT = (const f32x2*)(a.ws + WS_TOT) + (size_t)((seq * 4 + n) * 8) * 2 * 64;
    if (tid < 128) { const int dir = tid >> 6, c = tid & 63, ch = n * 64 + c;
        float cv = lat ? a.in[I_SLRU][(size_t)((b * 4 + layer) * 2 + dir) * 256 + ch] : 0.f; float mine = cv;
        f32x2 ev[8];
#pragma unroll
        for (int k = 0; k < 8; ++k) ev[k] = k < nc ? TOT[(size_t)(k * 2 + dir) * 64 + c] : (f32x2){1.f, 0.f};
#pragma unroll
        for (int k = 0; k < 8; ++k) { const int cj = dir == 0 ? k : 7 - k; if (cj < nc) { if (cj == ci) mine = cv; cv = ev[cj].x * cv + ev[cj].y; } }
        (dir == 0 ? CF : CB)[c] = mine;
        if (!lat && ci == 0) a.out[O_SLRU + (size_t)((b * 4 + layer) * 2 + dir) * 256 + ch] = cv; }
    __syncthreads();
#pragma unroll
    for (int r = 0; r < 4; ++r) { const int idx = tid + NT * r, t = ci * 128 + (idx >> 4), c4 = (idx & 15) * 4; const size_t row = (size_t)(row0 + t);
        const f32x4 cf = *(LAS const f32x4*)(CF + c4), cb = *(LAS const f32x4*)(CB + c4);
        const float gv[4] = {bflo(gz[r].x), bfhi(gz[r].x), bflo(gz[r].y), bfhi(gz[r].y)};
        float y[4];
#pragma unroll
        for (int e = 0; e < 4; ++e) { const float u3 = 0.7978845608028654f * (gv[e] + 0.044715f * gv[e] * gv[e] * gv[e]), th = 1.f - 2.f * rcp_(1.f + __expf(2.f * u3));
            y[e] = (hs[r][e] + pf[r][e] * cf[e] + pb[r][e] * cb[e]) * (0.5f * gv[e] * (1.f + th)); }
        u32x2 wv; wv.x = pk2(y[0], y[1]); wv.y = pk2(y[2], y[3]);
        *(u32x2*)(Y + row * DM + 256 + n * 64 + c4) = wv; }
}

constexpr int U_GEMM = 0, U_LRUA_LAT = 16, U_LRUA_CTX = 272, U_DIFF_LAT = 400, U_RET_LAT = 656, U_SWA_LAT = 912, U_RET_CTX = 1168, U_SWA_CTX = 1296, U_RST = 1424, U_LRUB_LAT = 1488, U_LRUB_CTX = 1744, U_DIFF_CTX = 1872, U_END = 2000;
__device__ __forceinline__ void mix_phase(const Args& a0, LAS unsigned char* lds, int layer_in, const int wave_s__, const int xcc) {
    volatile LAS int* sh = (volatile LAS int*)(lds + LDS_MISC);
    unsigned* ctr = (unsigned*)(a0.ws + WS_CTL) + 64 * (1 + layer_in);
    unsigned* dcnt = (unsigned*)(a0.ws + WS_CTL) + 64 * (9 + layer_in);
    unsigned* ctrq = (unsigned*)(a0.ws + WS_CTL) + 2048 + layer_in * 512;
    int qtry = 0; bool head_done = false;
#define MIX_CLAIM(dst) do { int u_ = U_END; \
        if (!head_done) { const int v_ = (int)atomicAdd(ctr, 1u); if (v_ < 16) u_ = v_; else head_done = true; } \
        while (u_ == U_END && qtry < 8) { const int q_ = (xcc + qtry) & 7; const int v_ = (int)atomicAdd(ctrq + 64 * q_, 1u); \
            if (v_ < 248) { \
                if (v_ < 32) u_ = U_LRUA_LAT + q_ * 32 + v_; else if (v_ < 48) u_ = U_LRUA_CTX + q_ * 16 + (v_ - 32); else if (v_ < 80) u_ = U_DIFF_LAT + q_ * 32 + (v_ - 48); \
                else if (v_ < 112) u_ = U_RET_LAT + q_ * 32 + (v_ - 80); else if (v_ < 144) u_ = U_SWA_LAT + q_ * 32 + (v_ - 112); else if (v_ < 160) u_ = U_RET_CTX + q_ * 16 + (v_ - 144); \
                else if (v_ < 176) u_ = U_SWA_CTX + q_ * 16 + (v_ - 160); else if (v_ < 184) u_ = U_RST + q_ * 8 + (v_ - 176); else if (v_ < 216) u_ = U_LRUB_LAT + q_ * 32 + (v_ - 184); \
                else if (v_ < 232) u_ = U_LRUB_CTX + q_ * 16 + (v_ - 216); else u_ = U_DIFF_CTX + q_ * 16 + (v_ - 232); \
            } else ++qtry; } \
        dst = u_; } while (0)
    int nxt = U_END;
    if (TIDX == 0) MIX_CLAIM(nxt);
    for (;;) {
        __syncthreads();
        if (TIDX == 0) sh[0] = nxt;
        __syncthreads();
        const int u = sh[0];
        if (u >= U_END) break;
        if (TIDX == 0) MIX_CLAIM(nxt);
        auto kp = __builtin_amdgcn_kernarg_segment_ptr(); asm volatile("" : "+s"(kp));
        const Args& a = *(const Args*)kp;
        int layer = layer_in; asm volatile("" : "+s"(layer));
        if (u < U_LRUA_LAT) {
            unsigned char* wsl = a.ws;
            pg8::Gemm gm{(const bf16*)(wsl + WS_XB), (const bf16*)(wsl + WS_WIN) + (size_t)layer * DIN * DM, NTOK, DIN, DM}; OneUnit S{u, 8};
            EpiIn E{(bf16*)(wsl + WS_Z), (const float*)(wsl + WS_SS), (const float*)(wsl + WS_B1) + (size_t)layer * NG * DIN, a.out, (const f32x4*)(wsl + WS_CS64), (const f32x4*)(wsl + WS_CS32), layer};
            pg8::gemm_phase<EpiIn, OneUnit, true, true>(lds, gm, S, E, wave_s__);
            asm volatile("s_waitcnt vmcnt(0)" ::: "memory"); __syncthreads();
            if (TIDX == 0) { __builtin_amdgcn_fence(__ATOMIC_RELEASE, "agent"); asm volatile("s_waitcnt vmcnt(0)" ::: "memory"); __hip_atomic_fetch_add((GAS unsigned*)dcnt, 1u, __ATOMIC_RELAXED, __HIP_MEMORY_SCOPE_AGENT); }
        }
        else if (u < U_LRUA_CTX) { const int r = u - U_LRUA_LAT; lru_a_unit(a, lds, layer, 16 + (r >> 5), (r >> 3) & 3, r & 7, wave_s__); }
        else if (u < U_DIFF_LAT) { const int r = u - U_LRUA_CTX; lru_a_unit(a, lds, layer, r >> 3, (r >> 1) & 3, r & 1, wave_s__); }
        else if (u < U_RET_LAT) { const int r = u - U_DIFF_LAT; attn_unit<2>(a, lds, layer, 16 + (r >> 5), (r >> 3) & 3, r & 7, wave_s__); }
        else if (u < U_SWA_LAT) { const int r = u - U_RET_LAT; attn_unit<0>(a, lds, layer, 16 + (r >> 5), (r >> 3) & 3, r & 7, wave_s__); }
        else if (u < U_RET_CTX) { const int r = u - U_SWA_LAT; attn_unit<1>(a, lds, layer, 16 + (r >> 5), (r >> 3) & 3, r & 7, wave_s__); }
        else if (u < U_SWA_CTX) { const int r = u - U_RET_CTX; attn_unit<0>(a, lds, layer, r >> 3, (r >> 1) & 3, r & 1, wave_s__); }
        else if (u < U_RST) { const int r = u - U_SWA_CTX; attn_unit<1>(a, lds, layer, r >> 3, (r >> 1) & 3, r & 1, wave_s__); }
        else if (u < U_LRUB_LAT) { const int r = u - U_RST; ret_state_unit(a, lds, layer, r >> 2, r & 3, wave_s__); }
        else if (u < U_LRUB_CTX) { const int r = u - U_LRUB_LAT; lru_b_unit(a, lds, layer, 16 + (r >> 5), (r >> 3) & 3, r & 7, wave_s__); }
        else if (u < U_DIFF_CTX) { const int r = u - U_LRUB_CTX; lru_b_unit(a, lds, layer, r >> 3, (r >> 1) & 3, r & 1, wave_s__); }
        else { const int r = u - U_DIFF_CTX;
            wait_count(dcnt, 16u, TIDX == 0);
            attn_unit<2>(a, lds, layer, r >> 3, (r >> 1) & 3, r & 1, wave_s__); }
    }
#undef MIX_CLAIM
}

__device__ __forceinline__ void prep_transposes(const Args& a, LAS unsigned char* lds, int l, int vb, int nb, const int wave_s__) {
    int tid_l = TIDX; asm volatile("" : "+v"(tid_l));
    const int lane = tid_l & 63, wave = tid_l >> 6;
    unsigned char* ws = a.ws;
    LAS float* scr = (LAS float*)(lds + wave * 16384);
    constexpr int IT_IN = (DM / 64) * (DIN / 32), IT_OUT = (DM / 64) * (DM / 32), IT_F1 = (DM / 64) * (DFF / 32), IT_F2 = (DFF / 64) * (DM / 32), IT_L = IT_IN + IT_OUT + IT_F1 + IT_F2;
    for (int it = vb * 8 + wave; it < IT_L; it += nb * 8) { int r = it;
        if (r < IT_IN) { transpose_item<true>(a.in[I_WIN] + (size_t)l * DM * DIN, DM, DIN, (bf16*)(ws + WS_WIN) + (size_t)l * DIN * DM, scr, r, lane); continue; } r -= IT_IN;
        if (r < IT_OUT) { transpose_item<false>(a.in[I_WOUT] + (size_t)l * DM * DM, DM, DM, (bf16*)(ws + WS_WOUT) + (size_t)l * DM * DM, scr, r, lane); continue; } r -= IT_OUT;
        if (r < IT_F1) { transpose_item<false>(a.in[I_WFF1] + (size_t)l * DM * DFF, DM, DFF, (bf16*)(ws + WS_WFF1) + (size_t)l * DFF * DM, scr, r, lane); continue; } r -= IT_F1;
        transpose_item<false>(a.in[I_WFF2] + (size_t)l * DFF * DM, DFF, DM, (bf16*)(ws + WS_WFF2) + (size_t)l * DM * DFF, scr, r, lane); }
}
__device__ __forceinline__ void prep_bias(const Args& a, LAS unsigned char* lds, int l, int vb, int nb, const int wave_s__) {
    unsigned char* ws = a.ws; const float* m = (const float*)(ws + WS_MOD) + (size_t)l * NG * NMOD;
    for (int r = vb; r < DIN / 64 + DFF / 64; r += nb) {
        if (r < DIN / 64) gemv_item<false, true>(lds, a.in[I_WIN] + (size_t)l * DM * DIN, DIN, r * 64, m, m + NMOD, NMOD, nullptr, (float*)(ws + WS_B1) + (size_t)l * NG * DIN, DIN, wave_s__);
        else gemv_item<false, false>(lds, a.in[I_WFF1] + (size_t)l * DM * DFF, DFF, (r - DIN / 64) * 64, m + 3072, m + NMOD + 3072, NMOD, nullptr, (float*)(ws + WS_B2) + (size_t)l * NG * DFF, DFF, wave_s__); }
}

#define XB_TMO      128
#define XB_XCNT(j)  (256  + 64 * (j))
#define XB_XSUB(j)  (1280 + 64 * (j))
#define XB_XGEN(j)  (2304 + 64 * (j))
#define XB_TOP      3328
#define XB_TOPGEN   3392
#define XCD_BAR_WORDS 3456
#define XB_SPIN_CAP (1u << 18)

__device__ __forceinline__ unsigned xb_ld(unsigned* p)              { return __hip_atomic_load(p, __ATOMIC_RELAXED, __HIP_MEMORY_SCOPE_AGENT); }
__device__ __forceinline__ unsigned xb_add(unsigned* p, unsigned v) { return __hip_atomic_fetch_add(p, v, __ATOMIC_RELAXED, __HIP_MEMORY_SCOPE_AGENT); }
__device__ __forceinline__ unsigned xb_xcc_id() { return (unsigned)__builtin_amdgcn_s_getreg((3 << 11) | 20) & 0xFu; }
#define XB_SPIN(cond, bar) do { unsigned _sp = 0; while (cond) { __builtin_amdgcn_s_sleep(1); \
    if ((++_sp & 255u) == 0u) { if (xb_ld(&(bar)[XB_TMO])) break; if (_sp > XB_SPIN_CAP) { atomicAdd(&(bar)[XB_TMO], 1u); break; } } } } while (0)

struct XcdBarrier {
    unsigned* bar; unsigned x;
    volatile LAS unsigned* st;
};

__device__ __forceinline__ XcdBarrier xcd_barrier_post(unsigned* bar, volatile LAS unsigned* st, const int wave_s__) {
    XcdBarrier b; b.bar = bar; b.x = xb_xcc_id(); b.st = st;
    if (TIDX == 0) (void)xb_add(&bar[XB_XCNT(b.x)], 1u);
    return b;
}
__device__ __forceinline__ void xcd_barrier_complete(unsigned* bar, unsigned x, unsigned& nloc, unsigned& nx) {
    const unsigned G = gridDim.x * gridDim.y * gridDim.z;
    unsigned sum, cnt, mine, sp = 0u;
    for (;;) {
        sum = 0u; cnt = 0u; mine = 0u;
#pragma unroll
        for (unsigned j = 0; j < 16; ++j) { const unsigned c = xb_ld(&bar[XB_XCNT(j)]); sum += c; cnt += (c > 0u) ? 1u : 0u; mine = (j == x) ? c : mine; }
        if (sum == G) break;
        __builtin_amdgcn_s_sleep(1);
        if ((++sp & 255u) == 0u) { if (xb_ld(&bar[XB_TMO])) break; if (sp > XB_SPIN_CAP) { atomicAdd(&bar[XB_TMO], 1u); break; } }
    }
    nloc = mine > 0u ? mine : 1u; nx = cnt > 0u ? cnt : 1u;
}

__device__ __forceinline__ void xcd_barrier(const XcdBarrier& b, const int wave_s__) {
    asm volatile("s_waitcnt vmcnt(0)" ::: "memory");
    __syncthreads();
    if (TIDX == 0) {
        unsigned* bar = b.bar;
        __builtin_amdgcn_s_waitcnt(0);
        unsigned nloc = b.st[0], nx = b.st[1];
        const unsigned old = xb_add(&bar[XB_XSUB(b.x)], 1u);
        const unsigned gen = old / nloc;
        if (old + 1u == (gen + 1u) * nloc) {
            __builtin_amdgcn_fence(__ATOMIC_RELEASE, "agent");
            asm volatile("s_waitcnt vmcnt(0)" ::: "memory");
            const unsigned og = xb_add(&bar[XB_TOP], 1u);
            const unsigned tg = og / nx;
            if (og + 1u == (tg + 1u) * nx) xb_add(&bar[XB_TOPGEN], 1u);
            else XB_SPIN(xb_ld(&bar[XB_TOPGEN]) == tg, bar);
            __builtin_amdgcn_fence(__ATOMIC_ACQUIRE, "agent");
            xb_add(&bar[XB_XGEN(b.x)], 1u);
            asm volatile("s_waitcnt vmcnt(0)" ::: "memory");
        } else {
            XB_SPIN(xb_ld(&bar[XB_XGEN(b.x)]) == gen, bar);
            __builtin_amdgcn_fence(__ATOMIC_ACQUIRE, "agent");
            asm volatile("s_waitcnt vmcnt(0)" ::: "memory");
        }
    }
    __syncthreads();
}

__global__ void __launch_bounds__(NT, 2) fwd_megakernel(Args a) {
    extern __shared__ __attribute__((aligned(16))) unsigned char lds_raw[];
    LAS unsigned char* lds = (LAS unsigned char*)lds_raw;
    cg::grid_group grid = cg::this_grid();
    const int wave_s__ = __builtin_amdgcn_readfirstlane((int)threadIdx.x >> 6);
    const int tid = TIDX, lane = tid & 63, wave = wave_s__, G = gridDim.x, bid = blockIdx.x;
    if (tid < 64) ((LAS unsigned*)(lds + LDS_MISC))[tid] = 0u;
    __syncthreads();
    const XcdBarrier bar = xcd_barrier_post((unsigned*)(a.ws + WS_CTL) + CW_BAR, (volatile LAS unsigned*)(lds + LDS_MISC) + 8, wave_s__);
#define GRID_BAR() do { XcdBarrier bb_ = bar; asm volatile("" : "+s"(bb_.x)); xcd_barrier(bb_, wave_s__); } while (0)
    const int gw = bid * 8 + wave, NGW = G * 8;
    {
    unsigned char* ws = a.ws;
    float* MOD = (float*)(ws + WS_MOD); float* GM = (float*)(ws + WS_GM); float* B1 = (float*)(ws + WS_B1); float* B2 = (float*)(ws + WS_B2);
    float* SS = (float*)(ws + WS_SS); float* X = (float*)(ws + WS_X); bf16* XB = (bf16*)(ws + WS_XB); bf16* Z = (bf16*)(ws + WS_Z); bf16* Y = (bf16*)(ws + WS_Y); bf16* H = (bf16*)(ws + WS_H);
    bf16* WIN = (bf16*)(ws + WS_WIN); bf16* WOUT = (bf16*)(ws + WS_WOUT); bf16* WFF1 = (bf16*)(ws + WS_WFF1); bf16* WFF2 = (bf16*)(ws + WS_WFF2);

    for (int it = bid; it < 4 * (NMOD / 64); it += G) { const int l = it / (NMOD / 64), n0 = (it % (NMOD / 64)) * 64;
        gemv_item<true, false>(lds, a.in[I_WADA] + (size_t)l * DM * NMOD, NMOD, n0, a.in[I_CCTX], a.in[I_C], DM, a.in[I_BADA] + (size_t)l * NMOD, MOD + (size_t)l * NG * NMOD, NMOD, wave_s__); }
    __syncthreads();
    prep_transposes(a, lds, 0, bid, G, wave_s__);
    for (int i = bid * NT + tid; i < 4 * 2 * 2 * 4 * 4096; i += G * NT) {
        const int c = i & 63, d = (i >> 6) & 63, nb = (i >> 12) & 3, gate = (i >> 14) & 1, ld = i >> 15;
        ((bf16*)(ws + WS_WLRU))[i] = (bf16)f2bf(a.in[gate ? I_LWX : I_LWA][((size_t)(ld * 4 + nb) * 64 + c) * 64 + d]); }
    for (int i = bid * NT + tid; i < 1024 * 32 + 1024 * 16; i += G * NT) {
        if (i < 1024 * 32) { const int pos = i >> 5, k = i & 31; const float inv = exp2f(-(float)(k & 15) * (13.287712379549449f / 16.f)); const float ang = (float)(k < 16 ? (pos >> 6) : (pos & 63)) * inv;
            ((f32x2*)(ws + WS_CS64))[i] = (f32x2){cosf(ang), sinf(ang)}; }
        else { const int j = i - 1024 * 32, pos = j >> 4, k = j & 15; const float inv = exp2f(-(float)(k & 7) * (13.287712379549449f / 8.f)); const float ang = (float)(k < 8 ? (pos >> 6) : (pos & 63)) * inv;
            ((f32x2*)(ws + WS_CS32))[j] = (f32x2){cosf(ang), sinf(ang)}; }
    }
    if (a.ws == nullptr) grid.sync();
    if (tid == 0) { unsigned nloc, nx; xcd_barrier_complete(bar.bar, bar.x, nloc, nx); bar.st[0] = nloc; bar.st[1] = nx; }
    __syncthreads();
    GRID_BAR();
    prep_bias(a, lds, 0, bid, G, wave_s__);
    for (int i = bid * NT + tid; i < 4 * 2 * NG * DM; i += G * NT) { const int k = i & 1023, g = (i >> 10) % NG, which = (i / (NG * DM)) & 1, l = i / (2 * NG * DM);
        GM[i] = a.in[which ? I_NMLPG : I_NMIXG][l * DM + k] * (1.f + MOD[((size_t)l * NG + g) * NMOD + (which ? 4096 : 1024) + k]); }
    for (int rowa = gw; rowa < NTOK; rowa += 2 * NGW) {
        f32x4 xv[2][4], ngv[4], scv[2][4]; bool ok[2];
#pragma unroll
        for (int j = 0; j < 4; ++j) ngv[j] = *(const f32x4*)(a.in[I_NMIXG] + 4 * lane + 256 * j);
#pragma unroll
        for (int q = 0; q < 2; ++q) { const int row = rowa + q * NGW; ok[q] = row < NTOK;
            if (ok[q]) { const float* xr = row < NCTX ? a.in[I_XP] + (size_t)row * DM : a.in[I_XS] + (size_t)(row - NCTX) * DM; const int g = grp_of_row(row);
#pragma unroll
                for (int j = 0; j < 4; ++j) { const int c = 4 * lane + 256 * j; xv[q][j] = *(const f32x4*)(xr + c); scv[q][j] = *(const f32x4*)(MOD + (size_t)g * NMOD + 1024 + c); } } }
#pragma unroll
        for (int q = 0; q < 2; ++q) if (ok[q]) { const int row = rowa + q * NGW;
            float s = 0.f;
#pragma unroll
            for (int j = 0; j < 4; ++j) { const int c = 4 * lane + 256 * j; const f32x4 v = xv[q][j], ng = ngv[j], sc = scv[q][j]; s += (v[0] * v[0] + v[1] * v[1]) + (v[2] * v[2] + v[3] * v[3]);
                { u32x2 xw; xw.x = pk2(v[0], v[1]); xw.y = pk2(v[2], v[3]); *(u32x2*)((bf16*)X + (size_t)row * DM + c) = xw; }
                u32x2 wv; wv.x = pk2(v[0] * ng[0] * (1.f + sc[0]), v[1] * ng[1] * (1.f + sc[1])); wv.y = pk2(v[2] * ng[2] * (1.f + sc[2]), v[3] * ng[3] * (1.f + sc[3]));
                *(u32x2*)(XB + (size_t)row * DM + c) = wv; }
            s = wave_sum(s);
            if (lane < 16) SS[(size_t)row * 16 + lane] = lane == 0 ? s : 0.f; }
    }
    }
    GRID_BAR();
#define FRESH_WS() unsigned char* wsl = a.ws; asm volatile("" : "+s"(wsl))
#pragma unroll 1
    for (int l = 0; l < 4; ++l) {
        {   FRESH_WS();
            pg8::Gemm gm{(const bf16*)(wsl + WS_XB), (const bf16*)(wsl + WS_WIN) + (size_t)l * DIN * DM, NTOK, DIN, DM}; InOrder S{G, bid};
            EpiIn E{(bf16*)(wsl + WS_Z), (const float*)(wsl + WS_SS), (const float*)(wsl + WS_B1) + (size_t)l * NG * DIN, a.out, (const f32x4*)(wsl + WS_CS64), (const f32x4*)(wsl + WS_CS32), l};
            pg8::gemm_phase<EpiIn, InOrder, true, true>(lds, gm, S, E, wave_s__); }
        GRID_BAR();
        mix_phase(a, lds, l, wave_s__, (int)bar.x);
        GRID_BAR();
        {   FRESH_WS();
            pg8::Gemm gm{(const bf16*)(wsl + WS_Y), (const bf16*)(wsl + WS_WOUT) + (size_t)l * DM * DM, NTOK, DM, DM}; pg8::StaticOrder S; S.init(NTOK, DM, G, bid);
            EpiRes E{(bf16*)(wsl + WS_X), (bf16*)(wsl + WS_XB), (float*)(wsl + WS_SS), (const float*)(wsl + WS_MOD) + (size_t)l * NG * NMOD + 2048, (const float*)(wsl + WS_GM) + (size_t)(l * 2 + 1) * NG * DM};
            pg8::gemm_phase<EpiRes, pg8::StaticOrder, true, true>(lds, gm, S, E, wave_s__); }
        if (l < 3) { const int nb = G > 192 ? G - 192 : G, vb = G > 192 ? bid - 192 : bid; if (vb >= 0) prep_bias(a, lds, l + 1, vb, nb, wave_s__); }
        GRID_BAR();
        {   FRESH_WS();
            pg8::Gemm gm{(const bf16*)(wsl + WS_XB), (const bf16*)(wsl + WS_WFF1) + (size_t)l * DFF * DM, NTOK, DFF, DM}; pg8::StaticOrder S; S.init(NTOK, DFF, G, bid);
            EpiFF1 E{(bf16*)(wsl + WS_H), (const float*)(wsl + WS_SS), (const float*)(wsl + WS_B2) + (size_t)l * NG * DFF};
            pg8::gemm_phase<EpiFF1, pg8::StaticOrder, true, true>(lds, gm, S, E, wave_s__); }
        GRID_BAR();
        {   FRESH_WS();
            pg8::Gemm gm{(const bf16*)(wsl + WS_H), (const bf16*)(wsl + WS_WFF2) + (size_t)l * DM * DFF, NTOK, DM, DFF}; pg8::StaticOrder S; S.init(NTOK, DM, G, bid);
            EpiRes E{(bf16*)(wsl + WS_X), (bf16*)(wsl + WS_XB), (float*)(wsl + WS_SS), (const float*)(wsl + WS_MOD) + (size_t)l * NG * NMOD + 5120, l < 3 ? (const float*)(wsl + WS_GM) + (size_t)((l + 1) * 2 + 0) * NG * DM : nullptr};
            pg8::gemm_phase<EpiRes, pg8::StaticOrder, true, true>(lds, gm, S, E, wave_s__); }
        if (l < 3) { const int nb = G > 192 ? G - 192 : G, vb = G > 192 ? bid - 192 : bid; if (vb >= 0) prep_transposes(a, lds, l + 1, vb, nb, wave_s__); }
        GRID_BAR();
    }
    FRESH_WS();
    int tid_f = TIDX; asm volatile("" : "+v"(tid_f));
    const int lane_f = tid_f & 63, gw_f = bid * 8 + (tid_f >> 6);
    for (int row = gw_f; row < NTOK; row += NGW) {
        const f32x4 sa = *(const f32x4*)((const float*)(wsl + WS_SS) + (size_t)row * 16 + 4 * (lane_f & 3));
        u32x2 xw[4]; f32x4 fgv[4];
#pragma unroll
        for (int j = 0; j < 4; ++j) { const int c = 4 * lane_f + 256 * j; xw[j] = *(const u32x2*)((const bf16*)(wsl + WS_X) + (size_t)row * DM + c); fgv[j] = *(const f32x4*)(a.in[I_FNG] + c); }
        float ps = (sa[0] + sa[1]) + (sa[2] + sa[3]);
        ps += asf_(__builtin_amdgcn_update_dpp(0, asu_(ps), 0xB1, 0xF, 0xF, true)); ps += asf_(__builtin_amdgcn_update_dpp(0, asu_(ps), 0x4E, 0xF, 0xF, true));
        const float rs = rsqrtf(ps * (1.f / DM) + EPS);
#pragma unroll
        for (int j = 0; j < 4; ++j) { const int c = 4 * lane_f + 256 * j; const f32x4 v = {bflo(xw[j].x), bfhi(xw[j].x), bflo(xw[j].y), bfhi(xw[j].y)};
            *(f32x4*)(a.out + (size_t)row * DM + c) = v * rs * fgv[j]; }
    }
}

extern "C" void kernel_launch(void* const* d_in, const int* in_sizes, int n_in, void* d_out, int out_size, void* d_ws, size_t ws_size, hipStream_t stream) {
    static int grid = 0;
    if (grid == 0) {
        if (n_in != N_IN || ws_size < WS_END) { fprintf(stderr, "kernel_launch: expected %d inputs and >= %zu bytes of workspace, got %d / %zu\n", (int)N_IN, (size_t)WS_END, n_in, ws_size); grid = -1; return; }
        int dev = 0, cus = 0, per_cu = 0;
        (void)hipGetDevice(&dev); (void)hipDeviceGetAttribute(&cus, hipDeviceAttributeMultiprocessorCount, dev);
        if (hipFuncSetAttribute((const void*)fwd_megakernel, hipFuncAttributeMaxDynamicSharedMemorySize, LDS_BYTES) != hipSuccess) { fprintf(stderr, "kernel_launch: hipFuncSetAttribute failed\n"); grid = -1; return; }
        if (hipOccupancyMaxActiveBlocksPerMultiprocessor(&per_cu, (const void*)fwd_megakernel, NT, LDS_BYTES) != hipSuccess || per_cu < 1) { fprintf(stderr, "kernel_launch: occupancy query gave %d\n", per_cu); per_cu = 1; }
        (void)hipGetLastError();
        grid = cus * 1;
        fprintf(stderr, "kernel_launch: grid %d (cus %d, per_cu %d)\n", grid, cus, per_cu);
    }
    if (grid < 0) return;
    (void)hipMemsetAsync((char*)d_ws + WS_CTL, 0, 32768, stream);
    Args a{};
    for (int i = 0; i < N_IN; ++i) a.in[i] = (const float*)d_in[i];
    a.out = (float*)d_out; a.ws = (unsigned char*)d_ws;
    void* args[] = {&a};
    hipError_t e = hipLaunchCooperativeKernel((const void*)fwd_megakernel, dim3(grid), dim3(NT), args, LDS_BYTES, stream);
    if (e != hipSuccess) fprintf(stderr, "kernel_launch: cooperative launch failed: %s (grid %d)\n", hipGetErrorString(e), grid);
}
```

```cpp
#include <hip/hip_runtime.h>
#include <hip/hip_cooperative_groups.h>
#include <cstdio>
#include <cstdint>
namespace cg = cooperative_groups;
#define TIDX ((int)(wave_s__ * 64 + (int)__builtin_amdgcn_mbcnt_hi(~0u, __builtin_amdgcn_mbcnt_lo(~0u, 0u))))
namespace pg8 {
#define PG8_LAS __attribute__((address_space(3)))
typedef unsigned short bf16_t;
typedef short bf16x8 __attribute__((ext_vector_type(8)));
typedef float f32x4 __attribute__((ext_vector_type(4)));
typedef unsigned u32x4 __attribute__((ext_vector_type(4)));
constexpr int BM = 256, BK = 64, HALF = 128, HTB = HALF * BK * 2  , STAGE_BYTES = 8 * HTB, NXCD = 8, WGM = 8;

__host__ __device__ __forceinline__ int lds_byte(int r, int c) { const int st = (r >> 4) * 2 + (c >> 5), rr = r & 15, cc = c & 31, ob = rr * 64 + cc * 2; return st * 1024 + (ob ^ (((ob >> 9) & 1) << 5)); }
__host__ __device__ __forceinline__ void stage_rc(int b, int& R, int& C) { const int st = b / 1024, sb = b % 1024, swz = sb ^ (((sb >> 9) & 1) << 5); R = (st >> 1) * 16 + swz / 64; C = (st & 1) * 32 + (swz % 64) / 2; }
__host__ __device__ __forceinline__ int perm32(int rho) { const int n = rho >> 4, i = rho & 15; return 8 * (i >> 2) + 4 * n + (i & 3); }

struct Unit { int pm, pn; };
struct Gemm { const bf16_t* A; const bf16_t* Bt; int M, N, K; };

struct StaticOrder {
    int nM, nN, nwg, G, c;
    __host__ __device__ void init(int M, int N, int G_, int c_) { nM = M / BM; nN = N / BM; nwg = nM * nN; G = G_; c = c_; }
    __host__ __device__ bool next(int i, Unit& u) const {
        const long L = (long)i * G + c; if (L >= nwg) return false;
        int wgid = (int)L; { const int q = nwg / NXCD, r = nwg % NXCD, xcd = wgid % NXCD, off = wgid / NXCD; wgid = (xcd < r ? xcd * (q + 1) : r * (q + 1) + (xcd - r) * q) + off; }
        const int nig = WGM * nN, gid = wgid / nig, fm = gid * WGM, gsz = (nM - fm) < WGM ? (nM - fm) : WGM;
        u.pm = fm + ((wgid % nig) % gsz); u.pn = (wgid % nig) / gsz; return true;
    }
    __device__ __forceinline__ void a_ready(const Unit&) const {}
    __device__ __forceinline__ void done(const Unit&) const {}
};
__device__ __forceinline__ unsigned cvt_pk_bf16(float lo, float hi) { unsigned r; asm volatile("v_cvt_pk_bf16_f32 %0, %1, %2" : "=v"(r) : "v"(lo), "v"(hi)); return r; }

template <class Epi, class Sched, bool ALIGN_EPI = false, bool SP2 = false>
__device__ __forceinline__ void gemm_phase(PG8_LAS unsigned char* lds, const Gemm g, const Sched& S, const Epi& E, const int wave_s__) {
    int tid_l = TIDX; asm volatile("" : "+v"(tid_l));
    const int tid = tid_l, wid = __builtin_amdgcn_readfirstlane(tid >> 6), lane = tid & 63, wr = wid >> 2, wc = wid & 3, fr = lane & 15, fq = lane >> 4;
    const int K = g.K, nt = K / BK;
    unsigned voffA[2], voffB[2];
#pragma unroll
    for (int i = 0; i < 2; ++i) { int R, C; stage_rc(tid * 16 + i * 8192, R, C); const int Rb = Epi::PERM ? ((R & ~31) + perm32(R & 31)) : R;
        voffA[i] = (unsigned)(R * K + C) * 2u; voffB[i] = (unsigned)(Rb * K + C) * 2u; }
    const size_t kstep = (size_t)(BK * 2);
    const size_t hstep = (size_t)HALF * K * 2;
    const size_t tstep = 2 * hstep;
    const unsigned ldsw = (unsigned)wid * 1024u;
    const int aoff = lds_byte(wr * 64 + fr, fq * 8), boff = lds_byte(wc * 32 + fr, fq * 8);
#define PG8_SA(b, h) (((b) * 2 + (h)) * HTB)
#define PG8_SB(b, h) ((4 + (b) * 2 + (h)) * HTB)
#define PG8_STAGE(bufoff, gbase, voff) do { _Pragma("unroll") for (int _i = 0; _i < 2; ++_i) \
        __builtin_amdgcn_global_load_lds((const unsigned*)((const char*)(gbase) + (voff)[_i]), (PG8_LAS unsigned*)(lds + (bufoff) + ldsw + _i * 8192), 16, 0, 0); } while (0)
#define PG8_LDA(dst, b, h) do { _Pragma("unroll") for (int m = 0; m < 4; ++m) _Pragma("unroll") for (int k = 0; k < 2; ++k) dst[m][k] = *(const PG8_LAS bf16x8*)(lds + PG8_SA(b, h) + aoff + m * 2048 + k * 1024); } while (0)
#define PG8_LDB(dst, b, h) do { _Pragma("unroll") for (int n = 0; n < 2; ++n) _Pragma("unroll") for (int k = 0; k < 2; ++k) dst[n][k] = *(const PG8_LAS bf16x8*)(lds + PG8_SB(b, h) + boff + n * 2048 + k * 1024); } while (0)
#define PG8_MMA(ai, bj, At, Bt) do { __builtin_amdgcn_s_setprio(1); _Pragma("unroll") for (int m = 0; m < 4; ++m) _Pragma("unroll") for (int n = 0; n < 2; ++n) _Pragma("unroll") for (int k = 0; k < 2; ++k) \
        acc[ai][bj][m][n] = __builtin_amdgcn_mfma_f32_16x16x32_bf16(Bt[n][k], At[m][k], acc[ai][bj][m][n], 0, 0, 0); __builtin_amdgcn_s_setprio(0); } while (0)
#define PG8_WAIT_V(n) asm volatile("s_waitcnt vmcnt(" #n ")" ::: "memory")
#define PG8_WAIT_L(n) asm volatile("s_waitcnt lgkmcnt(" #n ")" ::: "memory")
#define PG8_BAR __builtin_amdgcn_s_barrier()
#define PG8_SCHED __builtin_amdgcn_sched_barrier(0)
    Unit cur, nxt; int ui = 0;
    if (!S.next(0, cur)) return;
    f32x4 acc[2][2][4][2];
#pragma unroll
    for (int a = 0; a < 2; ++a)
#pragma unroll
        for (int b = 0; b < 2; ++b)
#pragma unroll
            for (int m = 0; m < 4; ++m)
#pragma unroll
                for (int n = 0; n < 2; ++n) acc[a][b][m][n] = (f32x4){0.f, 0.f, 0.f, 0.f};
    bf16x8 At[4][2], B0[2][2], B1[2][2];
    const char* cA = (const char*)g.A + (size_t)cur.pm * tstep; const char* cB = (const char*)g.Bt + (size_t)cur.pn * tstep;
    S.a_ready(cur);
    if constexpr (SP2) {
        PG8_STAGE(PG8_SB(0, 0), cB, voffB); PG8_STAGE(PG8_SB(0, 1), cB + hstep, voffB); PG8_STAGE(PG8_SA(0, 0), cA, voffA); PG8_STAGE(PG8_SA(0, 1), cA + hstep, voffA);
        if (wr == 1) PG8_BAR;
        PG8_WAIT_V(2); PG8_BAR;
        PG8_STAGE(PG8_SB(1, 0), cB + kstep, voffB); PG8_STAGE(PG8_SA(1, 0), cA + kstep, voffA); PG8_STAGE(PG8_SB(1, 1), cB + hstep + kstep, voffB);
        PG8_WAIT_V(6); PG8_BAR;
    } else {
        PG8_STAGE(PG8_SB(0, 0), cB, voffB); PG8_STAGE(PG8_SA(0, 0), cA, voffA); PG8_STAGE(PG8_SB(0, 1), cB + hstep, voffB); PG8_STAGE(PG8_SA(0, 1), cA + hstep, voffA);
        if (wr == 1) PG8_BAR;
        PG8_WAIT_V(4); PG8_BAR;
        PG8_STAGE(PG8_SB(1, 0), cB + kstep, voffB); PG8_STAGE(PG8_SA(1, 0), cA + kstep, voffA); PG8_STAGE(PG8_SB(1, 1), cB + hstep + kstep, voffB);
        PG8_WAIT_V(6); PG8_BAR;
    }
    for (;;) {
        const bool has_next = S.next(ui + 1, nxt);
        const char* nA = has_next ? (const char*)g.A + (size_t)nxt.pm * tstep : cA; const char* nB = has_next ? (const char*)g.Bt + (size_t)nxt.pn * tstep : cB;
        for (int t = 0; t < nt; t += 2) {
            const bool last = (t == nt - 2);
            const char* a1 = cA + (size_t)(t + 1) * kstep;
            const char* a2 = last ? nA : cA + (size_t)(t + 2) * kstep; const char* b2 = last ? nB : cB + (size_t)(t + 2) * kstep;
            const char* a3 = a2 + kstep; const char* b3 = b2 + kstep;
            if (last && has_next) S.a_ready(nxt);
            if constexpr (SP2) {
            PG8_LDB(B0, 0, 0); PG8_LDB(B1, 0, 1); PG8_SCHED; PG8_LDA(At, 0, 0); PG8_STAGE(PG8_SA(1, 1), a1 + hstep, voffA);
            PG8_WAIT_V(8); PG8_WAIT_L(0); PG8_BAR; PG8_MMA(0, 0, At, B0); PG8_MMA(0, 1, At, B1); PG8_BAR; PG8_SCHED;
            PG8_LDA(At, 0, 1); PG8_STAGE(PG8_SB(0, 0), b2, voffB); PG8_STAGE(PG8_SB(0, 1), b2 + hstep, voffB); PG8_STAGE(PG8_SA(0, 0), a2, voffA);
            PG8_WAIT_V(8); PG8_WAIT_L(0); PG8_BAR; PG8_MMA(1, 0, At, B0); PG8_MMA(1, 1, At, B1); PG8_BAR; PG8_SCHED;
            PG8_LDB(B0, 1, 0); PG8_LDB(B1, 1, 1); PG8_SCHED; PG8_LDA(At, 1, 0); PG8_STAGE(PG8_SA(0, 1), a2 + hstep, voffA);
            PG8_WAIT_V(8); PG8_WAIT_L(0); PG8_BAR; PG8_MMA(0, 0, At, B0); PG8_MMA(0, 1, At, B1); PG8_BAR; PG8_SCHED;
            PG8_LDA(At, 1, 1); PG8_STAGE(PG8_SB(1, 0), b3, voffB); PG8_STAGE(PG8_SB(1, 1), b3 + hstep, voffB); PG8_STAGE(PG8_SA(1, 0), a3, voffA);
            PG8_WAIT_V(8); PG8_WAIT_L(0); PG8_BAR; PG8_MMA(1, 0, At, B0); PG8_MMA(1, 1, At, B1); PG8_BAR; PG8_SCHED;
            } else {
            PG8_LDB(B0, 0, 0); PG8_SCHED; PG8_LDA(At, 0, 0); PG8_STAGE(PG8_SA(1, 1), a1 + hstep, voffA);
            PG8_WAIT_L(8); PG8_BAR; PG8_WAIT_L(0); PG8_MMA(0, 0, At, B0); PG8_BAR; PG8_SCHED;
            PG8_LDB(B1, 0, 1); PG8_STAGE(PG8_SB(0, 0), b2, voffB);
            PG8_BAR; PG8_WAIT_L(0); PG8_MMA(0, 1, At, B1); PG8_BAR;
            PG8_LDA(At, 0, 1); PG8_STAGE(PG8_SA(0, 0), a2, voffA);
            PG8_BAR; PG8_WAIT_L(0); PG8_MMA(1, 0, At, B0); PG8_BAR; PG8_SCHED;
            PG8_STAGE(PG8_SB(0, 1), b2 + hstep, voffB);
            PG8_WAIT_V(6); PG8_BAR; PG8_MMA(1, 1, At, B1); PG8_BAR;
            PG8_LDB(B0, 1, 0); PG8_SCHED; PG8_LDA(At, 1, 0); PG8_STAGE(PG8_SA(0, 1), a2 + hstep, voffA);
            PG8_WAIT_L(8); PG8_BAR; PG8_WAIT_L(0); PG8_MMA(0, 0, At, B0); PG8_BAR; PG8_SCHED;
            PG8_LDB(B1, 1, 1); PG8_STAGE(PG8_SB(1, 0), b3, voffB);
            PG8_BAR; PG8_WAIT_L(0); PG8_MMA(0, 1, At, B1); PG8_BAR;
            PG8_LDA(At, 1, 1); PG8_STAGE(PG8_SA(1, 0), a3, voffA);
            PG8_BAR; PG8_WAIT_L(0); PG8_MMA(1, 0, At, B0); PG8_BAR; PG8_SCHED;
            PG8_STAGE(PG8_SB(1, 1), b3 + hstep, voffB);
            PG8_WAIT_V(6); PG8_BAR; PG8_MMA(1, 1, At, B1); PG8_BAR;
            }
        }
        if constexpr (ALIGN_EPI) { if (wr == 0) PG8_BAR; }
        if constexpr (!Epi::AFTER_DRAIN) { E(acc, cur, wr, wc, fr, fq); S.done(cur); }
        if (!has_next) break;
#pragma unroll
        for (int a = 0; a < 2; ++a)
#pragma unroll
            for (int b = 0; b < 2; ++b)
#pragma unroll
                for (int m = 0; m < 4; ++m)
#pragma unroll
                    for (int n = 0; n < 2; ++n) acc[a][b][m][n] = (f32x4){0.f, 0.f, 0.f, 0.f};
        cur = nxt; cA = nA; cB = nB; ++ui;
        if constexpr (ALIGN_EPI) { if (wr == 1) PG8_BAR; }
    }
    PG8_WAIT_V(0);
    if constexpr (!ALIGN_EPI) { if (wr == 0) PG8_BAR; }
    PG8_BAR;
    if constexpr (Epi::AFTER_DRAIN) { E.fused(acc, cur, wr, wc, fr, fq, lds, wid, lane); S.done(cur); }
#undef PG8_SA
#undef PG8_SB
#undef PG8_STAGE
#undef PG8_LDA
#undef PG8_LDB
#undef PG8_MMA
#undef PG8_WAIT_V
#undef PG8_WAIT_L
#undef PG8_BAR
#undef PG8_SCHED
}
}

#define LAS __attribute__((address_space(3)))
typedef unsigned short bf16;
typedef short bf16x8 __attribute__((ext_vector_type(8)));
typedef float f32x4 __attribute__((ext_vector_type(4)));
typedef unsigned u32x4 __attribute__((ext_vector_type(4)));
typedef unsigned u32x2 __attribute__((ext_vector_type(2)));
typedef float f32x2 __attribute__((ext_vector_type(2)));

constexpr int DM = 1024, DIN = 2816, DFF = 4096, NTOK = 12288, NCTX = 4096, NG = 9, NMOD = 6144;
constexpr float EPS = 1e-6f, LOG2E = 1.4426950408889634f;
constexpr int NT = 512;
enum { I_XP = 0, I_XS, I_C, I_SRET, I_SLRU, I_CSK, I_CSV, I_CDK, I_CDV, I_CCTX, I_WADA, I_BADA, I_NMIXG, I_WIN, I_RDEC, I_RGN, I_LCW, I_LCB,
       I_LWA, I_LBA, I_LWX, I_LBX, I_LLAM, I_SINK, I_DLAM, I_DNG, I_WOUT, I_NMLPG, I_WFF1, I_WFF2, I_FNG, N_IN };
constexpr size_t O_YP = 0, O_YS = 4194304, O_SRET = 12582912, O_SLRU = 14680064, O_SWAK = 14712832, O_SWAV = 16809984, O_DK = 18907136, O_DV = 23101440;
constexpr size_t MiB = 1u << 20;
constexpr size_t WS_CTL = 0, WS_MOD = 1 * MiB, WS_GM = 2 * MiB, WS_B1 = 3 * MiB, WS_B2 = 4 * MiB, WS_CS64 = 5 * MiB, WS_CS32 = 5 * MiB + 512 * 1024, WS_SS = 6 * MiB,
                 WS_WIN = 8 * MiB, WS_WOUT = 30 * MiB, WS_WFF1 = 38 * MiB, WS_WFF2 = 70 * MiB, WS_X = 102 * MiB, WS_XB = 150 * MiB, WS_Z = 174 * MiB, WS_Y = 240 * MiB,
                 WS_H = 264 * MiB, WS_END = 360 * MiB;
constexpr size_t WS_WLRU = 7 * MiB;
constexpr size_t WS_HS = WS_H, WS_PF = WS_H + 16 * MiB, WS_PB = WS_H + 32 * MiB, WS_TOT = WS_H + 48 * MiB;
constexpr int CW_LRU = 1024;
constexpr int LDS_BYTES = 139264;
constexpr int LDS_MISC = 131072;
constexpr int CW_BAR = 4096;

struct Args { const float* in[N_IN]; float* out; unsigned char* ws; };

__device__ __forceinline__ unsigned f2bf(float f) { unsigned u = __builtin_bit_cast(unsigned, f); return (u + 0x7fffu + ((u >> 16) & 1u)) >> 16; }
typedef float f32x2_t __attribute__((ext_vector_type(2))); typedef __bf16 bf16x2_t __attribute__((ext_vector_type(2)));
__device__ __forceinline__ unsigned pk2(float lo, float hi) { const f32x2_t v = {lo, hi}; const bf16x2_t b = __builtin_convertvector(v, bf16x2_t); return __builtin_bit_cast(unsigned, b); }
__host__ __device__ __forceinline__ int perm_in(int c) {
    if (c >= 1536 && c < 1920) { const int i = c & 63; return (c & ~63) + (i < 32 ? 2 * i : 2 * (i - 32) + 1); }
    if (c >= 2048 && c < 2560) { const int i = c & 31; return (c & ~31) + (i < 16 ? 2 * i : 2 * (i - 16) + 1); }
    return c;
}
__device__ __forceinline__ float bflo(unsigned w) { return __builtin_bit_cast(float, w << 16); }
__device__ __forceinline__ float bfhi(unsigned w) { return __builtin_bit_cast(float, w & 0xffff0000u); }
__device__ __forceinline__ float bf2f(bf16 v) { return __builtin_bit_cast(float, (unsigned)v << 16); }
__device__ __forceinline__ void unpack8(const u32x4 r, float (&f)[8]) { f[0] = bflo(r.x); f[1] = bfhi(r.x); f[2] = bflo(r.y); f[3] = bfhi(r.y); f[4] = bflo(r.z); f[5] = bfhi(r.z); f[6] = bflo(r.w); f[7] = bfhi(r.w); }
__device__ __forceinline__ u32x4 pack8(const float (&f)[8]) { u32x4 r; r.x = pk2(f[0], f[1]); r.y = pk2(f[2], f[3]); r.z = pk2(f[4], f[5]); r.w = pk2(f[6], f[7]); return r; }
__device__ __forceinline__ float ex2(float x) { return __builtin_amdgcn_exp2f(x); }
__device__ __forceinline__ float asf_(unsigned u) { return __builtin_bit_cast(float, u); }
__device__ __forceinline__ unsigned asu_(float f) { return __builtin_bit_cast(unsigned, f); }
__device__ __forceinline__ float sum_x16(float v) { const auto r = __builtin_amdgcn_permlane16_swap(asu_(v), asu_(v), false, false); return asf_(r[0]) + asf_(r[1]); }
__device__ __forceinline__ float sum_x32(float v) { const auto r = __builtin_amdgcn_permlane32_swap(asu_(v), asu_(v), false, false); return asf_(r[0]) + asf_(r[1]); }
__device__ __forceinline__ float max_x16(float v) { const auto r = __builtin_amdgcn_permlane16_swap(asu_(v), asu_(v), false, false); return fmaxf(asf_(r[0]), asf_(r[1])); }
__device__ __forceinline__ float max_x32(float v) { const auto r = __builtin_amdgcn_permlane32_swap(asu_(v), asu_(v), false, false); return fmaxf(asf_(r[0]), asf_(r[1])); }
__device__ __forceinline__ float wave_sum(float v) {
    v += asf_(__builtin_amdgcn_update_dpp(0, asu_(v), 0xB1, 0xF, 0xF, true));
    v += asf_(__builtin_amdgcn_update_dpp(0, asu_(v), 0x4E, 0xF, 0xF, true));
    v += asf_(__builtin_amdgcn_update_dpp(0, asu_(v), 0x141, 0xF, 0xF, true));
    v += asf_(__builtin_amdgcn_update_dpp(0, asu_(v), 0x140, 0xF, 0xF, true));
    v = sum_x16(v); return sum_x32(v);
}
__device__ __forceinline__ float rcp_(float x) { return __builtin_amdgcn_rcpf(x); }
__device__ __forceinline__ float sigmoidf_(float x) { return rcp_(1.f + __expf(-x)); }
__device__ __forceinline__ int grp_of_tile(int pm) { return pm < 16 ? 0 : 1 + ((pm - 16) >> 2); }
__device__ __forceinline__ int grp_of_row(int row) { return row < NCTX ? 0 : 1 + ((row - NCTX) >> 10); }
__device__ __forceinline__ float rstd_of(const float* SS, int row) {
    const f32x4* sp = (const f32x4*)(SS + (size_t)row * 16); const f32x4 a = sp[0], b = sp[1], c = sp[2], d = sp[3];
    const float s = ((a.x + a.y) + (a.z + a.w)) + ((b.x + b.y) + (b.z + b.w)) + ((c.x + c.y) + (c.z + c.w)) + ((d.x + d.y) + (d.z + d.w));
    return rsqrtf(s * (1.f / DM) + EPS);
}
__device__ __forceinline__ float rstd_of4(const float* SS, int row, int fq) {
    const f32x4 a = *(const f32x4*)(SS + (size_t)row * 16 + 4 * fq);
    float s = (a.x + a.y) + (a.z + a.w); s = sum_x16(s); s = sum_x32(s);
    return rsqrtf(s * (1.f / DM) + EPS);
}
#define GAS __attribute__((address_space(1)))
__device__ __forceinline__ void st_wt(float* p, float v) { __hip_atomic_store((GAS float*)p, v, __ATOMIC_RELAXED, __HIP_MEMORY_SCOPE_AGENT); }
__device__ __forceinline__ float ld_wt(const float* p) { return __hip_atomic_load((GAS float*)p, __ATOMIC_RELAXED, __HIP_MEMORY_SCOPE_AGENT); }
struct EpiIn {
    static constexpr bool PERM = true, AFTER_DRAIN = false;
    bf16* Z; const float* SS; const float* bias; float* out; const f32x4* cs64; const f32x4* cs32; int layer;
    __device__ __forceinline__ void operator()(const f32x4 (&acc)[2][2][4][2], const pg8::Unit& u, int wr, int wc, int fr_, int fq_) const {
        int fr = fr_, fq = fq_; asm volatile("" : "+v"(fr), "+v"(fq));
        const int g = grp_of_tile(u.pm), row0 = u.pm * 256 + wr * 64 + fr, ct0 = wc * 32 + 8 * fq, col0 = u.pn * 256 + ct0;
        const float* bp = bias + g * DIN + col0;
        f32x4 bv[2][2];
#pragma unroll
        for (int bj = 0; bj < 2; ++bj)
#pragma unroll
            for (int n = 0; n < 2; ++n) bv[bj][n] = *(const f32x4*)(bp + bj * 128 + 4 * n);
        const bool cache = (u.pm < 16) && (u.pn == 7 || u.pn == 9 || u.pn == 10);
        int rk[2] = {0, 0};
        if (u.pm >= 16) { if (u.pn == 6) { rk[0] = 64; rk[1] = 64; } else if (u.pn == 7) { rk[0] = 64; } else if (u.pn == 8 || u.pn == 9) { rk[0] = 32; rk[1] = 32; } }
#pragma unroll
        for (int ai = 0; ai < 2; ++ai)
#pragma unroll
            for (int m = 0; m < 4; ++m) {
                const int row = row0 + ai * 128 + m * 16; const float rs = rstd_of4(SS, row, fq);
#pragma unroll
                for (int bj = 0; bj < 2; ++bj) {
                    f32x4 v0 = acc[ai][bj][m][0] * rs + bv[bj][0], v1 = acc[ai][bj][m][1] * rs + bv[bj][1];
                    const int ct = ct0 + bj * 128;
                    if (rk[bj]) {
                        const int t = (row - NCTX) & 1023; f32x4 c01, c23;
                        if (rk[bj] == 64) { const float* tf = (const float*)cs64 + (size_t)t * 64 + (ct & 63); c01 = *(const f32x4*)tf; c23 = *(const f32x4*)(tf + 4); }
                        else { const float* tf = (const float*)cs32 + (size_t)t * 32 + (ct & 31); c01 = *(const f32x4*)tf; c23 = *(const f32x4*)(tf + 4); }
                        const float a0 = v0[0], b0 = v0[1], a1 = v0[2], b1 = v0[3], a2 = v1[0], b2 = v1[1], a3 = v1[2], b3 = v1[3];
                        v0[0] = a0 * c01[0] - b0 * c01[1]; v0[1] = a0 * c01[1] + b0 * c01[0]; v0[2] = a1 * c01[2] - b1 * c01[3]; v0[3] = a1 * c01[3] + b1 * c01[2];
                        v1[0] = a2 * c23[0] - b2 * c23[1]; v1[1] = a2 * c23[1] + b2 * c23[0]; v1[2] = a3 * c23[2] - b3 * c23[3]; v1[3] = a3 * c23[3] + b3 * c23[2];
                    }
                    u32x4 w; w.x = pk2(v0[0], v0[1]); w.y = pk2(v0[2], v0[3]); w.z = pk2(v1[0], v1[1]); w.w = pk2(v1[2], v1[3]);
                    *(u32x4*)(Z + (size_t)row * DIN + col0 + bj * 128) = w;
                    if (cache) {
                        const int b = u.pm, t = row - b * 256;
                        if (u.pn == 7 && bj == 0) {
                            float* dst = out + O_SWAK + ((size_t)(b * 4 + layer) * 256 + t) * 128 + (ct & ~63) + ((ct & 63) >> 1);
                            *(f32x4*)dst = (f32x4){v0[0], v0[2], v1[0], v1[2]}; *(f32x4*)(dst + 32) = (f32x4){v0[1], v0[3], v1[1], v1[3]};
                        } else if (u.pn == 9) {
                            float* dst = out + O_DK + ((size_t)(b * 4 + layer) * 256 + t) * 256 + (ct & ~31) + ((ct & 31) >> 1);
                            *(f32x4*)dst = (f32x4){v0[0], v0[2], v1[0], v1[2]}; *(f32x4*)(dst + 16) = (f32x4){v0[1], v0[3], v1[1], v1[3]};
                        } else {
                            float* dst = u.pn == 7 ? out + O_SWAV + ((size_t)(b * 4 + layer) * 256 + t) * 128 + ct - 128 : out + O_DV + ((size_t)(b * 4 + layer) * 256 + t) * 256 + ct;
                            *(f32x4*)dst = v0; *(f32x4*)(dst + 4) = v1;
                        }
                    }
                }
            }
    }
};
struct EpiRes {
    static constexpr bool PERM = true, AFTER_DRAIN = false;
    bf16* X; bf16* XB; float* SS; const float* gate; const float* gm;
    __device__ __forceinline__ void operator()(const f32x4 (&acc)[2][2][4][2], const pg8::Unit& u, int wr, int wc, int fr_, int fq_) const {
        int fr = fr_, fq = fq_; asm volatile("" : "+v"(fr), "+v"(fq));
        const int g = grp_of_tile(u.pm), row0 = u.pm * 256 + wr * 64 + fr, col0 = u.pn * 256 + wc * 32 + 8 * fq;
        f32x4 gv[2][2], mv[2][2];
#pragma unroll
        for (int bj = 0; bj < 2; ++bj)
#pragma unroll
            for (int n = 0; n < 2; ++n) { gv[bj][n] = *(const f32x4*)(gate + (size_t)g * NMOD + col0 + bj * 128 + 4 * n);
                mv[bj][n] = gm ? *(const f32x4*)(gm + (size_t)g * DM + col0 + bj * 128 + 4 * n) : (f32x4){0.f, 0.f, 0.f, 0.f}; }
#pragma unroll
        for (int ai = 0; ai < 2; ++ai) {
            u32x4 xr[4][2];
#pragma unroll
            for (int m = 0; m < 4; ++m)
#pragma unroll
                for (int bj = 0; bj < 2; ++bj) xr[m][bj] = *(const u32x4*)(X + (size_t)(row0 + ai * 128 + m * 16) * DM + col0 + bj * 128);
#pragma unroll
            for (int m = 0; m < 4; ++m) {
                const int row = row0 + ai * 128 + m * 16; float ss = 0.f;
#pragma unroll
                for (int bj = 0; bj < 2; ++bj) {
                    float xf[8]; unpack8(xr[m][bj], xf);
                    const f32x4 x0 = (f32x4){xf[0], xf[1], xf[2], xf[3]} + gv[bj][0] * acc[ai][bj][m][0], x1 = (f32x4){xf[4], xf[5], xf[6], xf[7]} + gv[bj][1] * acc[ai][bj][m][1];
                    u32x4 wx; wx.x = pk2(x0[0], x0[1]); wx.y = pk2(x0[2], x0[3]); wx.z = pk2(x1[0], x1[1]); wx.w = pk2(x1[2], x1[3]);
                    *(u32x4*)(X + (size_t)row * DM + col0 + bj * 128) = wx;
                    ss += (x0[0] * x0[0] + x0[1] * x0[1]) + (x0[2] * x0[2] + x0[3] * x0[3]) + (x1[0] * x1[0] + x1[1] * x1[1]) + (x1[2] * x1[2] + x1[3] * x1[3]);
                    if (gm) { const f32x4 y0 = x0 * mv[bj][0], y1 = x1 * mv[bj][1];
                        u32x4 w; w.x = pk2(y0[0], y0[1]); w.y = pk2(y0[2], y0[3]); w.z = pk2(y1[0], y1[1]); w.w = pk2(y1[2], y1[3]);
                        *(u32x4*)(XB + (size_t)row * DM + col0 + bj * 128) = w; }
                }
                ss = sum_x16(ss); ss = sum_x32(ss);
                if (fq == 0) SS[(size_t)row * 16 + u.pn * 4 + wc] = ss;
            }
        }
    }
};
struct EpiFF1 {
    static constexpr bool PERM = true, AFTER_DRAIN = false;
    bf16* H; const float* SS; const float* bias;
    __device__ __forceinline__ void operator()(const f32x4 (&acc)[2][2][4][2], const pg8::Unit& u, int wr, int wc, int fr_, int fq_) const {
        int fr = fr_, fq = fq_; asm volatile("" : "+v"(fr), "+v"(fq));
        const int g = grp_of_tile(u.pm), row0 = u.pm * 256 + wr * 64 + fr, col0 = u.pn * 256 + wc * 32 + 8 * fq;
        const float* bp = bias + g * DFF + col0;
        f32x4 bv[2][2];
#pragma unroll
        for (int bj = 0; bj < 2; ++bj)
#pragma unroll
            for (int n = 0; n < 2; ++n) bv[bj][n] = *(const f32x4*)(bp + bj * 128 + 4 * n);
#pragma unroll
        for (int ai = 0; ai < 2; ++ai)
#pragma unroll
            for (int m = 0; m < 4; ++m) {
                const int row = row0 + ai * 128 + m * 16; const float rs = rstd_of4(SS, row, fq);
#pragma unroll
                for (int bj = 0; bj < 2; ++bj) {
                    f32x4 v0 = acc[ai][bj][m][0] * rs + bv[bj][0], v1 = acc[ai][bj][m][1] * rs + bv[bj][1];
#pragma unroll
                    for (int e = 0; e < 4; ++e) { const float a = fmaxf(v0[e], 0.f), b = fmaxf(v1[e], 0.f); v0[e] = a * a; v1[e] = b * b; }
                    u32x4 w; w.x = pk2(v0[0], v0[1]); w.y = pk2(v0[2], v0[3]); w.z = pk2(v1[0], v1[1]); w.w = pk2(v1[2], v1[3]);
                    *(u32x4*)(H + (size_t)row * DFF + col0 + bj * 128) = w;
                }
            }
    }
};

struct InOrder {
    int G, c;
    __host__ __device__ static void decode(int w, int nM, int nN, int& pm, int& pn) {
        const int nwg = nM * nN, q = nwg / 8, r = nwg % 8, xcd = w % 8, off = w / 8; const int wg = (xcd < r ? xcd * (q + 1) : r * (q + 1) + (xcd - r) * q) + off;
        const int nig = 8 * nN, gid = wg / nig, fm = gid * 8, gsz = (nM - fm) < 8 ? (nM - fm) : 8; pm = fm + ((wg % nig) % gsz); pn = (wg % nig) / gsz;
    }
    __host__ __device__ bool next(int i, pg8::Unit& u) const {
        const long L = (long)i * G + c; if (L >= 512) return false;
        int pm, pn;
        if (L < 352) { decode((int)L, 32, 11, pm, pn); u.pm = 16 + pm; u.pn = pn; }
        else { decode((int)L - 352, 16, 10, pm, pn); u.pm = pm; u.pn = pn >= 8 ? pn + 1 : pn; }
        return true;
    }
    __device__ __forceinline__ void a_ready(const pg8::Unit&) const {}
    __device__ __forceinline__ void done(const pg8::Unit&) const {}
};
struct OneUnit {
    int pm, pn;
    __host__ __device__ bool next(int i, pg8::Unit& u) const { if (i != 0) return false; u.pm = pm; u.pn = pn; return true; }
    __device__ __forceinline__ void a_ready(const pg8::Unit&) const {}
    __device__ __forceinline__ void done(const pg8::Unit&) const {}
};

template <bool PERMIN>
__device__ __forceinline__ void transpose_item(const float* W, int K, int N, bf16* WT, LAS float* scr, int item, int lane) {
    const int nblk = N / 32, kb = item / nblk, nb = item % nblk, k0 = 64 * kb, n0 = 32 * nb;
    float wv[32];
#pragma unroll
    for (int i = 0; i < 32; ++i) wv[i] = __builtin_nontemporal_load(&W[(size_t)(k0 + 2 * i + (lane >> 5)) * N + n0 + (lane & 31)]);
#pragma unroll
    for (int i = 0; i < 32; ++i) scr[(2 * i + (lane >> 5)) * 33 + (lane & 31)] = wv[i];
    asm volatile("s_waitcnt lgkmcnt(0)" ::: "memory");
    const int c = lane & 7;
#pragma unroll
    for (int j = 0; j < 4; ++j) { const int n = (lane >> 3) + 8 * j; const LAS float* s = scr + (8 * c) * 33 + n;
        u32x4 o; o.x = pk2(s[0 * 33], s[1 * 33]); o.y = pk2(s[2 * 33], s[3 * 33]); o.z = pk2(s[4 * 33], s[5 * 33]); o.w = pk2(s[6 * 33], s[7 * 33]);
        __builtin_nontemporal_store(o, (u32x4*)(WT + (size_t)(PERMIN ? perm_in(n0 + n) : n0 + n) * K + k0 + 8 * c)); }
    asm volatile("s_waitcnt lgkmcnt(0)" ::: "memory");
}
template <bool SILU, bool PERMOUT>
__device__ __forceinline__ void gemv_item(LAS unsigned char* lds, const float* W, int N, int n0, const float* v0, const float* v1, int vs, const float* bias, float* out, int ldo, const int wave_s__) {
    LAS float* vl = (LAS float*)lds;
    LAS float* red = (LAS float*)(lds + 36864);
    int tid_l = TIDX; asm volatile("" : "+v"(tid_l));
    const int tid = tid_l, lane = tid & 63, w = tid >> 6;
    __syncthreads();
    {   float vv[NG * 1024 / NT];
#pragma unroll
        for (int r = 0; r < NG * 1024 / NT; ++r) { const int i = tid + NT * r, g = i >> 10, k = i & 1023; vv[r] = (g == 0) ? v0[k] : v1[(size_t)(g - 1) * vs + k]; }
#pragma unroll
        for (int r = 0; r < NG * 1024 / NT; ++r) { float v = vv[r]; if (SILU) v = v * sigmoidf_(v); vl[tid + NT * r] = v; } }
    __syncthreads();
    float acc[NG];
#pragma unroll
    for (int g = 0; g < NG; ++g) acc[g] = 0.f;
    const float* wp = W + (size_t)(w * 128) * N + n0 + lane;
    for (int k8 = 0; k8 < 128; k8 += 32) {
        float wv[32];
#pragma unroll
        for (int j = 0; j < 32; ++j) wv[j] = __builtin_nontemporal_load(&wp[(size_t)(k8 + j) * N]);
#pragma unroll
        for (int j = 0; j < 32; ++j)
#pragma unroll
            for (int g = 0; g < NG; ++g) acc[g] += vl[g * 1024 + w * 128 + k8 + j] * wv[j];
    }
#pragma unroll
    for (int g = 0; g < NG; ++g) red[(w * NG + g) * 64 + lane] = acc[g];
    __syncthreads();
    for (int i = tid; i < NG * 64; i += NT) { const int g = i >> 6, ln = i & 63; float s = 0.f;
#pragma unroll
        for (int ww = 0; ww < 8; ++ww) s += red[(ww * NG + g) * 64 + ln];
        out[(size_t)g * ldo + (PERMOUT ? perm_in(n0 + ln) : n0 + ln)] = s + (bias ? bias[n0 + ln] : 0.f); }
}

__device__ __forceinline__ f32x4 mfma16(bf16x8 a, bf16x8 b, f32x4 c) { return __builtin_amdgcn_mfma_f32_16x16x32_bf16(a, b, c, 0, 0, 0); }
constexpr int KS_STRIDE = 72, VT_STRIDE = 72;
constexpr int LDS_KS = 0, LDS_VT = 128 * KS_STRIDE * 2;
__device__ __forceinline__ float asf(unsigned u) { return __builtin_bit_cast(float, u); }

__device__ __forceinline__ void store_vt(LAS bf16* VT, int key, int c8, const u32x4 raw) { *(LAS u32x4*)(VT + key * VT_STRIDE + 8 * c8) = raw; }
typedef short v4i16_t __attribute__((ext_vector_type(4)));
__device__ __forceinline__ v4i16_t vtr(LAS const bf16* p) { return __builtin_amdgcn_ds_read_tr16_b64_v4i16((LAS v4i16_t*)p); }
struct Pre { u32x4 r[4]; };
__device__ __forceinline__ void pf_z(Pre& p, const bf16* Z, int rowbase, int kcol, int vcol, int tid) {
#pragma unroll
    for (int r = 0; r < 2; ++r) { const int idx = tid + NT * r, key = idx >> 3, c8 = idx & 7; const bf16* q = Z + (size_t)(rowbase + key) * DIN + 8 * c8;
        p.r[2 * r] = *(const u32x4*)(q + kcol); p.r[2 * r + 1] = *(const u32x4*)(q + vcol); }
}
__device__ __forceinline__ void st_z(const Pre& p, LAS bf16* Ks, LAS bf16* VT, int tid) {
#pragma unroll
    for (int r = 0; r < 2; ++r) { const int idx = tid + NT * r, key = idx >> 3, c8 = idx & 7; *(LAS u32x4*)(Ks + key * KS_STRIDE + 8 * c8) = p.r[2 * r]; store_vt(VT, key, c8, p.r[2 * r + 1]); }
}
template <int HD>
__device__ __forceinline__ void pf_cache(Pre& p, const float* CK, const float* CV, int rs, int tid) {
    const int key = tid >> 3, c8 = tid & 7, sub = HD == 64 ? 0 : (c8 >> 2) * 32, i0 = HD == 64 ? 4 * c8 : 4 * (c8 & 3);
    const float* kp = CK + (size_t)key * rs + sub + i0; const float* vp = CV + (size_t)key * rs + 8 * c8;
    p.r[0] = *(const u32x4*)kp; p.r[1] = *(const u32x4*)(kp + HD / 2); p.r[2] = *(const u32x4*)vp; p.r[3] = *(const u32x4*)(vp + 4);
}
__device__ __forceinline__ u32x4 pack_f32x8(const u32x4 a, const u32x4 b) { u32x4 w; w.x = pk2(asf(a.x), asf(a.y)); w.y = pk2(asf(a.z), asf(a.w)); w.z = pk2(asf(b.x), asf(b.y)); w.w = pk2(asf(b.z), asf(b.w)); return w; }
__device__ __forceinline__ void st_cache(const Pre& p, LAS bf16* Ks, LAS bf16* VT, int tid) {
    const int key = tid >> 3, c8 = tid & 7; const u32x4 e = p.r[0], o = p.r[1];
    u32x4 w; w.x = pk2(asf(e.x), asf(o.x)); w.y = pk2(asf(e.y), asf(o.y)); w.z = pk2(asf(e.z), asf(o.z)); w.w = pk2(asf(e.w), asf(o.w));
    *(LAS u32x4*)(Ks + key * KS_STRIDE + 8 * c8) = w; store_vt(VT, key, c8, pack_f32x8(p.r[2], p.r[3]));
}
__device__ __forceinline__ void pf_state(Pre& p, const float* S0, int tid) { const float* vp = S0 + (size_t)(tid >> 3) * 64 + 8 * (tid & 7); p.r[2] = *(const u32x4*)vp; p.r[3] = *(const u32x4*)(vp + 4); }
__device__ __forceinline__ void st_state(const Pre& p, LAS bf16* Ks, LAS bf16* VT, int tid) {
    const int key = tid >> 3, c8 = tid & 7; u32x4 r = {0u, 0u, 0u, 0u};
    if ((key >> 3) == c8) { const unsigned one = 0x3F80u << (16 * (key & 1)); const int wd = (key & 7) >> 1; r.x = wd == 0 ? one : 0u; r.y = wd == 1 ? one : 0u; r.z = wd == 2 ? one : 0u; r.w = wd == 3 ? one : 0u; }
    *(LAS u32x4*)(Ks + key * KS_STRIDE + 8 * c8) = r; store_vt(VT, key, c8, pack_f32x8(p.r[2], p.r[3]));
}

constexpr int LDS_SLOT = 2 * 128 * KS_STRIDE * 2, LDS_TAB = 2 * LDS_SLOT;
template <int NV>
__device__ __forceinline__ void softmax_step(float (&p)[NV], float& m, float& l, f32x4 (&o)[4], bool force) {
    bool big = force;
#pragma unroll
    for (int j = 0; j < NV; ++j) big |= p[j] > 8.f;
    if (__builtin_amdgcn_ballot_w64(big) != 0ull) {
        float mx = p[0];
#pragma unroll
        for (int j = 1; j < NV; ++j) mx = fmaxf(mx, p[j]);
        mx = max_x16(mx); mx = max_x32(mx);
        const bool mv = force || mx > 8.f;
        const float d = mv ? mx : 0.f, al = ex2(-d); m += d; l *= al;
#pragma unroll
        for (int j = 0; j < NV; ++j) p[j] -= d;
#pragma unroll
        for (int n = 0; n < 4; ++n) o[n] = o[n] * al;
    }
    float sum = 0.f;
#pragma unroll
    for (int j = 0; j < NV; ++j) { p[j] = ex2(p[j]); sum += p[j]; }
    l += sum;
}
template <int MODE, int KS>
__device__ __forceinline__ void attn_compute(LAS const bf16* Ks, LAS const bf16* VT, int nk, int kind, int kp0, int qpos, const bf16x8 (&qf)[2],
                                             f32x4 (&o)[4], f32x4 (&o2)[4], float& m1, float& l1, float& m2, float& l2, float c1, float lgf2, float lgb2, int g, int lq, bool first, LAS const float* tab) {
    constexpr int NTL = KS / 16, NV = KS / 4, NH = KS / 32;
    const f32x4 zero = {0.f, 0.f, 0.f, 0.f};
    float Af = 0.f, Ab = 0.f;
    if (MODE == 0 && kind == 2) { Af = ex2(lgf2 * (float)(qpos - kp0)); Ab = ex2(lgb2 * (float)(kp0 - qpos)); }
    for (int kk = 0; kk < nk / KS; ++kk) {
        f32x4 s[NTL], t[NTL];
        const f32x4 nm1 = {-m1, -m1, -m1, -m1}, nm2 = {-m2, -m2, -m2, -m2};
#pragma unroll
        for (int tt = 0; tt < NTL; ++tt) {
            LAS const bf16* kr = Ks + (kk * KS + tt * 16 + lq) * KS_STRIDE + 8 * g;
            const bf16x8 k0 = *(LAS const bf16x8*)kr, k1 = *(LAS const bf16x8*)(kr + 32);
            if (MODE == 2) { s[tt] = mfma16(k0, qf[0], nm1); t[tt] = mfma16(k1, qf[1], nm2); }
            else { s[tt] = mfma16(k0, qf[0], MODE == 1 ? nm1 : zero); s[tt] = mfma16(k1, qf[1], s[tt]); t[tt] = zero; }
        }
        float p[NV], p2[NV];
        if (MODE == 0) {
            if (kind == 2) {
                const int qlo = __builtin_amdgcn_readfirstlane(qpos - lq), klo = kp0 + kk * KS;
                if (klo + KS - 1 < qlo) {
#pragma unroll
                    for (int tt = 0; tt < NTL; ++tt) { const f32x4 cf = *(LAS const f32x4*)(tab + kk * KS + tt * 16 + 4 * g);
#pragma unroll
                        for (int i = 0; i < 4; ++i) p[tt * 4 + i] = s[tt][i] * (Af * cf[i]); }
                } else if (klo > qlo + 15) {
#pragma unroll
                    for (int tt = 0; tt < NTL; ++tt) { const f32x4 cb = *(LAS const f32x4*)(tab + 128 + kk * KS + tt * 16 + 4 * g);
#pragma unroll
                        for (int i = 0; i < 4; ++i) p[tt * 4 + i] = s[tt][i] * (Ab * cb[i]); }
                } else {
#pragma unroll
                    for (int tt = 0; tt < NTL; ++tt) { const int j0 = kk * KS + tt * 16 + 4 * g; const f32x4 cf = *(LAS const f32x4*)(tab + j0), cb = *(LAS const f32x4*)(tab + 128 + j0);
#pragma unroll
                        for (int i = 0; i < 4; ++i) { const int d = qpos - kp0 - j0 - i; const float f = d > 0 ? Af * cf[i] : (d < 0 ? Ab * cb[i] : 0.25f); p[tt * 4 + i] = s[tt][i] * f; } }
                }
            } else {
#pragma unroll
                for (int tt = 0; tt < NTL; ++tt)
#pragma unroll
                    for (int i = 0; i < 4; ++i) p[tt * 4 + i] = s[tt][i] * c1;
            }
        } else {
            bool masked = false;
            if (MODE == 1 && kind == 1) { const int qlo = __builtin_amdgcn_readfirstlane(qpos - lq), klo = kp0 + kk * KS; masked = (qlo + 15 - klo > 128) || (klo + KS - 1 - qlo > 128); }
#pragma unroll
            for (int tt = 0; tt < NTL; ++tt)
#pragma unroll
                for (int i = 0; i < 4; ++i) {
                    float v = s[tt][i];
                    if (MODE == 1 && masked) { const int d = qpos - (kp0 + kk * KS + tt * 16 + 4 * g + i); if (d > 128 || d < -128) v = -INFINITY; }
                    p[tt * 4 + i] = v;
                }
            softmax_step<NV>(p, m1, l1, o, MODE == 2 && first && kk == 0);
            if (MODE == 2) {
#pragma unroll
                for (int tt = 0; tt < NTL; ++tt)
#pragma unroll
                    for (int i = 0; i < 4; ++i) p2[tt * 4 + i] = t[tt][i];
                softmax_step<NV>(p2, m2, l2, o2, first && kk == 0);
            }
        }
        bf16x8 pf[NH], pf2[NH];
#pragma unroll
        for (int hh = 0; hh < NH; ++hh) {
            u32x4 w; w.x = pk2(p[8 * hh], p[8 * hh + 1]); w.y = pk2(p[8 * hh + 2], p[8 * hh + 3]); w.z = pk2(p[8 * hh + 4], p[8 * hh + 5]); w.w = pk2(p[8 * hh + 6], p[8 * hh + 7]);
            pf[hh] = __builtin_bit_cast(bf16x8, w); pf2[hh] = pf[hh];
            if (MODE == 2) { u32x4 w2; w2.x = pk2(p2[8 * hh], p2[8 * hh + 1]); w2.y = pk2(p2[8 * hh + 2], p2[8 * hh + 3]); w2.z = pk2(p2[8 * hh + 4], p2[8 * hh + 5]); w2.w = pk2(p2[8 * hh + 6], p2[8 * hh + 7]);
                pf2[hh] = __builtin_bit_cast(bf16x8, w2); }
        }
#pragma unroll
        for (int hh = 0; hh < NH; ++hh)
#pragma unroll
            for (int n = 0; n < 4; ++n) {
                LAS const bf16* vr = VT + (kk * KS + hh * 32 + 4 * g + (lq >> 2)) * VT_STRIDE + 16 * n + 4 * (lq & 3);
                const v4i16_t lo = vtr(vr), hi = vtr(vr + 16 * VT_STRIDE);
                const bf16x8 vf = {lo[0], lo[1], lo[2], lo[3], hi[0], hi[1], hi[2], hi[3]};
                o[n] = mfma16(vf, pf[hh], o[n]);
                if (MODE == 2) o2[n] = mfma16(vf, pf2[hh], o2[n]);
            }
    }
}

template <int MODE>
__device__ __forceinline__ void attn_unit(const Args& a, LAS unsigned char* lds, int layer, int seq, int h, int qb, const int wave_s__) {
    int tid_l = TIDX; asm volatile("" : "+v"(tid_l));
    const int tid = tid_l, lane = tid & 63, w = tid >> 6, g = lane >> 4, lq = lane & 15;
    const bool lat = seq >= 16; const int b = lat ? seq - 16 : seq, L = lat ? 1024 : 256, row0 = lat ? NCTX + b * 1024 : b * 256;
    const bf16* Z = (const bf16*)(a.ws + WS_Z); bf16* Y = (bf16*)(a.ws + WS_Y);
    LAS bf16* Ks = (LAS bf16*)(lds + LDS_KS); LAS bf16* VT = (LAS bf16*)(lds + LDS_VT);
    const int q0 = qb * 128, qpos = q0 + w * 16 + lq;
    const int kvh = MODE == 1 ? (h >> 1) : h;
    const int qcol = (MODE == 0 ? 0 : MODE == 1 ? 1536 : 2048) + h * 64, kcol = (MODE == 0 ? 256 : MODE == 1 ? 1792 : 2304) + kvh * 64, vcol = (MODE == 0 ? 512 : MODE == 1 ? 1920 : 2560) + kvh * 64;
    float m1 = 0.f, l1 = 0.f, m2 = 0.f, l2 = 0.f, c1 = 0.f, lgf2 = 0.f, lgb2 = 0.f;
    float xdf = 0.f, xdb = 0.f;
    if (MODE == 0) { xdf = a.in[I_RDEC][(layer * 2 + 0) * 4 + h]; xdb = a.in[I_RDEC][(layer * 2 + 1) * 4 + h]; }
    else if (MODE == 1) { c1 = 0.125f * LOG2E; m1 = a.in[I_SINK][layer * 4 + h] * LOG2E; l1 = (g == 0) ? 1.f : 0.f; }
    else { c1 = 0.17677669529663687f * LOG2E; }
    bf16x8 qf[2];
    { const bf16* qp = Z + (size_t)(row0 + qpos) * DIN + qcol;
#pragma unroll
      for (int ks = 0; ks < 2; ++ks) {
          u32x4 raw = *(const u32x4*)(qp + 32 * ks + 8 * g);
          if (MODE != 0) { float x[8]; unpack8(raw, x);
#pragma unroll
              for (int j = 0; j < 8; ++j) x[j] *= c1;
              raw = pack8(x); }
          qf[ks] = __builtin_bit_cast(bf16x8, raw);
      } }
    float lpa = 0.f, lpb = 0.f;
    if (MODE == 2 && lane < 32) { const float* lv = a.in[I_DLAM] + layer * 128; lpa = lv[lane] * lv[32 + lane]; lpb = lv[64 + lane] * lv[96 + lane]; }
    f32x4 o[4], o2[4];
#pragma unroll
    for (int n = 0; n < 4; ++n) { o[n] = (f32x4){0.f, 0.f, 0.f, 0.f}; o2[n] = (f32x4){0.f, 0.f, 0.f, 0.f}; }
    int ka0 = 0, ka1 = L;
    if (MODE == 1 && lat) { ka0 = q0 - 128 < 0 ? 0 : q0 - 128; ka1 = q0 + 256 > L ? L : q0 + 256; }
    const int kindA = MODE == 0 ? 2 : (MODE == 1 && lat) ? 1 : 0;
    const int nzc = (ka1 - ka0) >> 7, ntot = nzc + (lat ? (MODE == 0 ? 2 : 4) : 0);
    const float* CK = a.in[MODE == 1 ? I_CSK : I_CDK]; const float* CV = a.in[MODE == 1 ? I_CSV : I_CDV];
    const int rs = MODE == 1 ? 128 : 256; const size_t cbase = (size_t)(b * 4 + layer) * 256 * rs + kvh * 64;
    const float* S0 = a.in[I_SRET] + ((size_t)((b * 4 + layer) * 2) * 4 + h) * 4096;
    LAS const float* tab = (LAS const float*)(lds + LDS_TAB);
    LAS bf16* K0 = (LAS bf16*)lds; LAS bf16* V0 = K0 + 128 * KS_STRIDE; LAS bf16* K1 = (LAS bf16*)(lds + LDS_SLOT); LAS bf16* V1 = K1 + 128 * KS_STRIDE;
#define ATT_PF(P, cn) do { if ((cn) < ntot) { \
        if ((cn) < nzc) pf_z(P, Z, row0 + ka0 + 128 * (cn), kcol, vcol, tid); \
        else if (MODE == 0) pf_state(P, S0 + (size_t)((cn) - nzc) * 4 * 4096, tid); \
        else pf_cache<MODE == 1 ? 64 : 32>(P, CK + cbase + (size_t)((cn) - nzc) * 64 * rs, CV + cbase + (size_t)((cn) - nzc) * 64 * rs, rs, tid); } } while (0)
#define ATT_ST(P, c, KS_, VS_) do { if ((c) < nzc) st_z(P, KS_, VS_, tid); else if (MODE == 0) st_state(P, KS_, VS_, tid); else st_cache(P, KS_, VS_, tid); } while (0)
#define ATT_CMP(c, KS_, VS_) do { \
        if ((c) < nzc) attn_compute<MODE, (MODE == 2 ? 64 : 128)>(KS_, VS_, 128, kindA, ka0 + 128 * (c), qpos, qf, o, o2, m1, l1, m2, l2, c1, lgf2, lgb2, g, lq, (c) == 0, tab); \
        else if (MODE == 0) { const float rf = ((c) == nzc) ? ex2(lgf2 * (float)(qpos + 1)) : ex2(lgb2 * (float)(L - qpos)); \
            attn_compute<MODE, 64>(KS_, VS_, 64, 3, 0, qpos, qf, o, o2, m1, l1, m2, l2, rf, lgf2, lgb2, g, lq, false, tab); } \
        else attn_compute<MODE, 64>(KS_, VS_, 64, 0, 0, qpos, qf, o, o2, m1, l1, m2, l2, c1, lgf2, lgb2, g, lq, false, tab); } while (0)
    Pre preA, preB;
    ATT_PF(preA, 0); ATT_PF(preB, 1);
    if (MODE == 0) { lgf2 = -log1pf(__expf(-xdf)) * LOG2E; lgb2 = -log1pf(__expf(-xdb)) * LOG2E; }
    __syncthreads();
    if (MODE == 0 && tid < 256) ((LAS float*)(lds + LDS_TAB))[tid] = 0.125f * (tid < 128 ? ex2(-lgf2 * (float)tid) : ex2(lgb2 * (float)(tid - 128)));
    ATT_ST(preA, 0, K0, V0); ATT_PF(preA, 2);
    __syncthreads();
#pragma unroll 1
    for (int c = 0; c < ntot; c += 2) {
        if (c + 1 < ntot) { ATT_ST(preB, c + 1, K1, V1); ATT_PF(preB, c + 3); }
        ATT_CMP(c, K0, V0);
        __syncthreads();
        if (c + 1 < ntot) {
            if (c + 2 < ntot) { ATT_ST(preA, c + 2, K0, V0); ATT_PF(preA, c + 4); }
            ATT_CMP(c + 1, K1, V1);
            __syncthreads();
        }
    }
#undef ATT_PF
#undef ATT_ST
#undef ATT_CMP
    const size_t row = (size_t)(row0 + qpos);
    if (MODE == 0) {
        float s = 0.f;
#pragma unroll
        for (int n = 0; n < 4; ++n) s += (o[n][0] + o[n][1]) + (o[n][2] + o[n][3]);
        s = sum_x16(s); s = sum_x32(s);
        const float mu = s * (1.f / 64.f); float q = 0.f;
#pragma unroll
        for (int n = 0; n < 4; ++n)
#pragma unroll
            for (int i = 0; i < 4; ++i) { const float d = o[n][i] - mu; q += d * d; }
        q = sum_x16(q); q = sum_x32(q);
        const float rs = rsqrtf(q * (1.f / 64.f) + EPS);
        f32x4 gnv[4]; u32x2 gzv[4];
#pragma unroll
        for (int n = 0; n < 4; ++n) { const int dv = 16 * n + 4 * g; gnv[n] = *(const f32x4*)(a.in[I_RGN] + layer * 256 + h * 64 + dv); gzv[n] = *(const u32x2*)(Z + row * DIN + 768 + h * 64 + dv); }
#pragma unroll
        for (int n = 0; n < 4; ++n) {
            const int dv = 16 * n + 4 * g; const f32x4 gn = gnv[n];
            const u32x2 gz = gzv[n];
            const float z0 = bflo(gz.x), z1 = bfhi(gz.x), z2 = bflo(gz.y), z3 = bfhi(gz.y);
            const float y0 = (o[n][0] - mu) * rs * gn[0] * (z0 * sigmoidf_(z0)), y1 = (o[n][1] - mu) * rs * gn[1] * (z1 * sigmoidf_(z1));
            const float y2 = (o[n][2] - mu) * rs * gn[2] * (z2 * sigmoidf_(z2)), y3 = (o[n][3] - mu) * rs * gn[3] * (z3 * sigmoidf_(z3));
            u32x2 wv; wv.x = pk2(y0, y1); wv.y = pk2(y2, y3);
            *(u32x2*)(Y + row * DM + h * 64 + dv) = wv;
        }
    } else if (MODE == 1) {
        float lt = l1; lt = sum_x16(lt); lt = sum_x32(lt);
        const float inv = rcp_(lt);
#pragma unroll
        for (int n = 0; n < 4; ++n) { u32x2 wv; wv.x = pk2(o[n][0] * inv, o[n][1] * inv); wv.y = pk2(o[n][2] * inv, o[n][3] * inv);
            *(u32x2*)(Y + row * DM + 512 + h * 64 + 16 * n + 4 * g) = wv; }
    } else {
        float lt1 = l1; lt1 = sum_x16(lt1); lt1 = sum_x32(lt1);
        float lt2 = l2; lt2 = sum_x16(lt2); lt2 = sum_x32(lt2);
        float pa = wave_sum(lpa), pb = wave_sum(lpb);
        const float linit = 0.8f - 0.6f * __expf(-0.3f * (float)layer), lam = __expf(pa) - __expf(pb) + linit;
        const float i1 = rcp_(lt1), i2 = lam * rcp_(lt2); float q = 0.f;
#pragma unroll
        for (int n = 0; n < 4; ++n)
#pragma unroll
            for (int i = 0; i < 4; ++i) { const float v = o[n][i] * i1 - o2[n][i] * i2; o[n][i] = v; q += v * v; }
        q = sum_x16(q); q = sum_x32(q);
        const float rs = rsqrtf(q * (1.f / 64.f) + EPS) * (1.f - linit);
        f32x4 dgn[4];
#pragma unroll
        for (int n = 0; n < 4; ++n) dgn[n] = *(const f32x4*)(a.in[I_DNG] + layer * 64 + 16 * n + 4 * g);
#pragma unroll
        for (int n = 0; n < 4; ++n) { const int dv = 16 * n + 4 * g; const f32x4 gn = dgn[n];
            u32x2 wv; wv.x = pk2(o[n][0] * rs * gn[0], o[n][1] * rs * gn[1]); wv.y = pk2(o[n][2] * rs * gn[2], o[n][3] * rs * gn[3]);
            *(u32x2*)(Y + row * DM + 768 + h * 64 + dv) = wv; }
    }
}

__device__ __forceinline__ void ret_state_unit(const Args& a, LAS unsigned char* lds, int layer, int b, int h, const int wave_s__) {
    int tid_l = TIDX; asm volatile("" : "+v"(tid_l));
    const int tid = tid_l; const bf16* Z = (const bf16*)(a.ws + WS_Z);
    LAS bf16* Kl = (LAS bf16*)lds; LAS bf16* Vl = (LAS bf16*)(lds + 32768); LAS float* WF = (LAS float*)(lds + 65536); LAS float* WB = (LAS float*)(lds + 66560);
    const float xf = a.in[I_RDEC][(layer * 2 + 0) * 4 + h], xb = a.in[I_RDEC][(layer * 2 + 1) * 4 + h];
    const float lgf2 = -log1pf(__expf(-xf)) * LOG2E, lgb2 = -log1pf(__expf(-xb)) * LOG2E;
    __syncthreads();
    for (int idx = tid; idx < 256 * 8; idx += NT) { const int key = idx >> 3, c8 = idx & 7; const bf16* p = Z + (size_t)(b * 256 + key) * DIN + h * 64 + 8 * c8;
        *(LAS u32x4*)(Kl + key * 64 + 8 * c8) = *(const u32x4*)(p + 256); *(LAS u32x4*)(Vl + key * 64 + 8 * c8) = *(const u32x4*)(p + 512); }
    if (tid < 256) { WF[tid] = 0.125f * ex2(lgf2 * (float)(255 - tid)); WB[tid] = 0.125f * ex2(lgb2 * (float)tid); }
    __syncthreads();
    const int dk = tid >> 3, dv0 = (tid & 7) * 8;
    float af[8], ab[8];
#pragma unroll
    for (int i = 0; i < 8; ++i) { af[i] = 0.f; ab[i] = 0.f; }
    for (int s = 0; s < 256; ++s) {
        const float kv = bf2f(Kl[s * 64 + dk]), kf = kv * WF[s], kb = kv * WB[s];
        float v[8]; unpack8(*(LAS const u32x4*)(Vl + s * 64 + dv0), v);
#pragma unroll
        for (int i = 0; i < 8; ++i) { af[i] += kf * v[i]; ab[i] += kb * v[i]; }
    }
    float* of = a.out + O_SRET + ((size_t)((b * 4 + layer) * 2 + 0) * 4 + h) * 4096 + dk * 64 + dv0;
    float* ob = a.out + O_SRET + ((size_t)((b * 4 + layer) * 2 + 1) * 4 + h) * 4096 + dk * 64 + dv0;
    *(f32x4*)of = (f32x4){af[0], af[1], af[2], af[3]}; *(f32x4*)(of + 4) = (f32x4){af[4], af[5], af[6], af[7]};
    *(f32x4*)ob = (f32x4){ab[0], ab[1], ab[2], ab[3]}; *(f32x4*)(ob + 4) = (f32x4){ab[4], ab[5], ab[6], ab[7]};
}

__device__ __forceinline__ void publish_count(unsigned* cnt, bool leader) {
    asm volatile("s_waitcnt vmcnt(0)" ::: "memory"); __syncthreads();
    if (leader) __hip_atomic_fetch_add((GAS unsigned*)cnt, 1u, __ATOMIC_RELAXED, __HIP_MEMORY_SCOPE_AGENT);
}
__device__ __forceinline__ void wait_count(unsigned* cnt, unsigned target, bool leader) {
    if (leader) { unsigned sp = 0; while (__hip_atomic_load((GAS unsigned*)cnt, __ATOMIC_RELAXED, __HIP_MEMORY_SCOPE_AGENT) < target && ++sp < (1u << 22)) __builtin_amdgcn_s_sleep(2);
        __builtin_amdgcn_fence(__ATOMIC_ACQUIRE, "agent"); asm volatile("s_waitcnt vmcnt(0)" ::: "memory"); }
    __syncthreads();
}
constexpr int LA_XC = 0, LA_XCF = 18432, LA_WT = 51200, LA_WTOT = 88064, LA_CW = 96256;
__device__ __forceinline__ void lru_a_unit(const Args& a, LAS unsigned char* lds, int layer, int seq, int n, int ci, const int wave_s__) {
    int tid_l = TIDX; asm volatile("" : "+v"(tid_l));
    const int tid = tid_l, lane = tid & 63, w = tid >> 6, g = lane >> 4, lq = lane & 15;
    const bool lat = seq >= 16; const int b = lat ? seq - 16 : seq, L = lat ? 1024 : 256, row0 = lat ? NCTX + b * 1024 : b * 256, t0 = ci * 128;
    const bf16* Z = (const bf16*)(a.ws + WS_Z);
    LAS bf16* XC = (LAS bf16*)(lds + LA_XC); LAS float* XCF = (LAS float*)(lds + LA_XCF); LAS bf16* WT = (LAS bf16*)(lds + LA_WT);
    LAS f32x2* WTOT = (LAS f32x2*)(lds + LA_WTOT); LAS float* CW = (LAS float*)(lds + LA_CW);
    const int ct = tid >> 2, c16 = (tid & 3) * 16;
    u32x4 xr[4][2];
#pragma unroll
    for (int j = 0; j < 4; ++j) { const int tt = t0 + ct - 2 + j;
        if (tt >= 0 && tt < L) { const bf16* p = Z + (size_t)(row0 + tt) * DIN + 1024 + n * 64 + c16; xr[j][0] = *(const u32x4*)p; xr[j][1] = *(const u32x4*)(p + 8); }
        else { xr[j][0] = (u32x4){0u, 0u, 0u, 0u}; xr[j][1] = (u32x4){0u, 0u, 0u, 0u}; } }
    u32x4 wq[4];
#pragma unroll
    for (int m = 0; m < 4; ++m) wq[m] = *(const u32x4*)((const bf16*)(a.ws + WS_WLRU) + ((size_t)((layer * 2 + (m >> 1)) * 2 + (m & 1)) * 4 + n) * 4096 + tid * 8);
    float pba[2][4], pbx[2][4], plam[2][4];
#pragma unroll
    for (int dd = 0; dd < 2; ++dd)
#pragma unroll
        for (int nt = 0; nt < 4; ++nt) { const size_t pofs = (size_t)(layer * 2 + dd) * 256 + n * 64 + 16 * nt + lq; pba[dd][nt] = a.in[I_LBA][pofs]; pbx[dd][nt] = a.in[I_LBX][pofs]; plam[dd][nt] = a.in[I_LLAM][pofs]; }
    float cwv = 0.f; if (tid < 320) { const int j = tid >> 6, c = tid & 63; cwv = j < 4 ? a.in[I_LCW][(layer * 4 + j) * 256 + n * 64 + c] : a.in[I_LCB][layer * 256 + n * 64 + c]; }
    __syncthreads();
    if (tid < 320) CW[tid] = cwv;
#pragma unroll
    for (int m = 0; m < 4; ++m) *(LAS u32x4*)(WT + (m * 64 + (tid >> 3)) * 72 + (tid & 7) * 8) = wq[m];
    __syncthreads();
    {   float acc[16];
#pragma unroll
        for (int i = 0; i < 4; ++i) { const f32x4 cb = *(LAS const f32x4*)(CW + 256 + c16 + 4 * i); acc[4 * i] = cb[0]; acc[4 * i + 1] = cb[1]; acc[4 * i + 2] = cb[2]; acc[4 * i + 3] = cb[3]; }
#pragma unroll
        for (int j = 0; j < 4; ++j) { float x[16]; { float x0[8], x1[8]; unpack8(xr[j][0], x0); unpack8(xr[j][1], x1);
#pragma unroll
                for (int i = 0; i < 8; ++i) { x[i] = x0[i]; x[8 + i] = x1[i]; } }
#pragma unroll
            for (int i = 0; i < 4; ++i) { const f32x4 cw = *(LAS const f32x4*)(CW + j * 64 + c16 + 4 * i);
                acc[4 * i] += cw[0] * x[4 * i]; acc[4 * i + 1] += cw[1] * x[4 * i + 1]; acc[4 * i + 2] += cw[2] * x[4 * i + 2]; acc[4 * i + 3] += cw[3] * x[4 * i + 3]; } }
        u32x4 w0, w1; w0.x = pk2(acc[0], acc[1]); w0.y = pk2(acc[2], acc[3]); w0.z = pk2(acc[4], acc[5]); w0.w = pk2(acc[6], acc[7]);
        w1.x = pk2(acc[8], acc[9]); w1.y = pk2(acc[10], acc[11]); w1.z = pk2(acc[12], acc[13]); w1.w = pk2(acc[14], acc[15]);
        *(LAS u32x4*)(XC + ct * 72 + c16) = w0; *(LAS u32x4*)(XC + ct * 72 + c16 + 8) = w1;
#pragma unroll
        for (int i = 0; i < 4; ++i) *(LAS f32x4*)(XCF + ct * 64 + c16 + 4 * i) = (f32x4){acc[4 * i], acc[4 * i + 1], acc[4 * i + 2], acc[4 * i + 3]};
    }
    __syncthreads();
    LAS const bf16* xrow = XC + (16 * w + lq) * 72 + 8 * g;
    const bf16x8 x0 = *(LAS const bf16x8*)xrow, x1 = *(LAS const bf16x8*)(xrow + 32);
    float hf[4][4];
    float* HS = (float*)(a.ws + WS_HS); float* PF = (float*)(a.ws + WS_PF); float* PB = (float*)(a.ws + WS_PB);
    f32x2* TOT = (f32x2*)(a.ws + WS_TOT) + ((size_t)((seq * 4 + n) * 8 + ci) * 2) * 64;
#pragma unroll 1
    for (int dir = 0; dir < 2; ++dir) {
        float P[4][4], hh[4][4];
        float PT[4], HT[4];
#pragma unroll
        for (int nt = 0; nt < 4; ++nt) {
            const f32x4 zero = {0.f, 0.f, 0.f, 0.f};
            LAS const bf16* wa = WT + ((dir * 2 + 0) * 64 + 16 * nt + lq) * 72 + 8 * g; LAS const bf16* wx = WT + ((dir * 2 + 1) * 64 + 16 * nt + lq) * 72 + 8 * g;
            f32x4 Ga = mfma16(x0, *(LAS const bf16x8*)wa, zero); Ga = mfma16(x1, *(LAS const bf16x8*)(wa + 32), Ga);
            f32x4 Gx = mfma16(x0, *(LAS const bf16x8*)wx, zero); Gx = mfma16(x1, *(LAS const bf16x8*)(wx + 32), Gx);
            const float ba = dir == 0 ? pba[0][nt] : pba[1][nt], bx = dir == 0 ? pbx[0][nt] : pbx[1][nt], lmv = dir == 0 ? plam[0][nt] : plam[1][nt];
            const float sp8 = 8.f * 0.6931471805599453f * __log2f(1.f + __expf(-lmv));
            float av[4], uv[4];
#pragma unroll
            for (int i = 0; i < 4; ++i) { const int t = 16 * w + 4 * g + i;
                const float r = sigmoidf_(Ga[i] + ba), ig = sigmoidf_(Gx[i] + bx), la = -r * sp8; av[i] = __expf(la);
                const float x2 = 2.f * la;
                const float ser = -x2 * (1.f + x2 * (0.5f + x2 * (0.16666667f + x2 * (0.041666668f + x2 * (0.0083333338f + x2 * 0.0013888889f)))));
                const float om = x2 > -0.25f ? ser : 1.f - av[i] * av[i];
                uv[i] = __builtin_amdgcn_sqrtf(fmaxf(om, 0.f)) * ig * XCF[t * 64 + 16 * nt + lq]; }
            float pp = 1.f, h = 0.f;
#pragma unroll
            for (int i = 0; i < 4; ++i) { const int ii = dir == 0 ? i : 3 - i; h = av[ii] * h + uv[ii]; pp *= av[ii]; P[nt][ii] = pp; hh[nt][ii] = h; }
            PT[nt] = pp; HT[nt] = h;
        }
        const int rk = dir == 0 ? g : 3 - g;
        float Pe[4], He[4];
#pragma unroll
        for (int nt = 0; nt < 4; ++nt) {
#pragma unroll
            for (int k = 1; k <= 2; k <<= 1) { const int src = ((dir == 0 ? lane - 16 * k : lane + 16 * k) & 63) << 2;
                const float Pp = asf_((unsigned)__builtin_amdgcn_ds_bpermute(src, (int)asu_(PT[nt]))), hp = asf_((unsigned)__builtin_amdgcn_ds_bpermute(src, (int)asu_(HT[nt])));
                if (rk >= k) { HT[nt] = PT[nt] * hp + HT[nt]; PT[nt] = PT[nt] * Pp; } }
            const int src = ((dir == 0 ? lane - 16 : lane + 16) & 63) << 2;
            Pe[nt] = asf_((unsigned)__builtin_amdgcn_ds_bpermute(src, (int)asu_(PT[nt]))); He[nt] = asf_((unsigned)__builtin_amdgcn_ds_bpermute(src, (int)asu_(HT[nt])));
            if (rk == 0) { Pe[nt] = 1.f; He[nt] = 0.f; }
            if (rk == 3) WTOT[(w * 2 + dir) * 64 + 16 * nt + lq] = (f32x2){PT[nt], HT[nt]};
        }
        __syncthreads();
#pragma unroll
        for (int nt = 0; nt < 4; ++nt) {
            float Pw = 1.f, hw = 0.f;
#pragma unroll
            for (int k = 0; k < 8; ++k) { const int w2 = dir == 0 ? k : 7 - k; const bool before = dir == 0 ? (w2 < w) : (w2 > w);
                const f32x2 e = WTOT[(w2 * 2 + dir) * 64 + 16 * nt + lq]; if (before) { hw = e.x * hw + e.y; Pw = e.x * Pw; } }
            const float Pex = Pe[nt] * Pw, hex = Pe[nt] * hw + He[nt];
            const int ch = n * 64 + 16 * nt + lq;
#pragma unroll
            for (int i = 0; i < 4; ++i) { const size_t idx = (size_t)(row0 + t0 + 16 * w + 4 * g + i) * 256 + ch;
                const float hv = P[nt][i] * hex + hh[nt][i], pv = P[nt][i] * Pex;
                if (dir == 0) { hf[nt][i] = hv; st_wt(PF + idx, pv); } else { st_wt(HS + idx, hf[nt][i] + hv); st_wt(PB + idx, pv); }
                if (rk == 3 && w == (dir == 0 ? 7 : 0) && i == (dir == 0 ? 3 : 0)) { float* tp = (float*)(TOT + dir * 64 + 16 * nt + lq); st_wt(tp, pv); st_wt(tp + 1, hv); } }
        }
    }
    publish_count((unsigned*)(a.ws + WS_CTL) + CW_LRU + layer * 128 + seq * 4 + n, tid == 0);
}
__device__ __forceinline__ void lru_b_unit(const Args& a, LAS unsigned char* lds, int layer, int seq, int n, int ci, const int wave_s__) {
    int tid_l = TIDX; asm volatile("" : "+v"(tid_l));
    const int tid = tid_l;
    const bool lat = seq >= 16; const int b = lat ? seq - 16 : seq, L = lat ? 1024 : 256, row0 = lat ? NCTX + b * 1024 : b * 256, nc = L / 128;
    unsigned* cnt = (unsigned*)(a.ws + WS_CTL) + CW_LRU + layer * 128 + seq * 4 + n;
    wait_count(cnt, (unsigned)nc, tid == 0);
    const bf16* Z = (const bf16*)(a.ws + WS_Z); bf16* Y = (bf16*)(a.ws + WS_Y);
    const float* HS = (const float*)(a.ws + WS_HS); const float* PF = (const float*)(a.ws + WS_PF); const float* PB = (const float*)(a.ws + WS_PB);
    f32x4 hs[4], pf[4], pb[4]; u32x2 gz[4];
#pragma unroll
    for (int r = 0; r < 4; ++r) { const int idx = tid + NT * r, t = ci * 128 + (idx >> 4), c4 = (idx & 15) * 4; const size_t row = (size_t)(row0 + t);
        hs[r] = *(const f32x4*)(HS + row * 256 + n * 64 + c4); pf[r] = *(const f32x4*)(PF + row * 256 + n * 64 + c4); pb[r] = *(const f32x4*)(PB + row * 256 + n * 64 + c4);
        gz[r] = *(const u32x2*)(Z + row * DIN + 1280 + n * 64 + c4); }
    LAS float* CF = (LAS float*)lds; LAS float* CB = CF + 64;
    const f32x2* TOT = (const f32x2*)(a.ws + WS_TOT) + (size_t)((seq * 4 + n) * 8) * 2 * 64;
    if (tid < 128) { const int dir = tid >> 6, c = tid & 63, ch = n * 64 + c;
        float cv = lat ? a.in[I_SLRU][(size_t)((b * 4 + layer) * 2 + dir) * 256 + ch] : 0.f; float mine = cv;
        f32x2 ev[8];
#pragma unroll
        for (int k = 0; k < 8; ++k) ev[k] = k < nc ? TOT[(size_t)(k * 2 + dir) * 64 + c] : (f32x2){1.f, 0.f};
#pragma unroll
        for (int k = 0; k < 8; ++k) { const int cj = dir == 0 ? k : 7 - k; if (cj < nc) { if (cj == ci) mine = cv; cv = ev[cj].x * cv + ev[cj].y; } }
        (dir == 0 ? CF : CB)[c] = mine;
        if (!lat && ci == 0) a.out[O_SLRU + (size_t)((b * 4 + layer) * 2 + dir) * 256 + ch] = cv; }
    __syncthreads();
#pragma unroll
    for (int r = 0; r < 4; ++r) { const int idx = tid + NT * r, t = ci * 128 + (idx >> 4), c4 = (idx & 15) * 4; const size_t row = (size_t)(row0 + t);
        const f32x4 cf = *(LAS const f32x4*)(CF + c4), cb = *(LAS const f32x4*)(CB + c4);
        const float gv[4] = {bflo(gz[r].x), bfhi(gz[r].x), bflo(gz[r].y), bfhi(gz[r].y)};
        float y[4];
#pragma unroll
        for (int e = 0; e < 4; ++e) { const float u3 = 0.7978845608028654f * (gv[e] + 0.044715f * gv[e] * gv[e] * gv[e]), th = 1.f - 2.f * rcp_(1.f + __expf(2.f * u3));
            y[e] = (hs[r][e] + pf[r][e] * cf[e] + pb[r][e] * cb[e]) * (0.5f * gv[e] * (1.f + th)); }
        u32x2 wv; wv.x = pk2(y[0], y[1]); wv.y = pk2(y[2], y[3]);
        *(u32x2*)(Y + row * DM + 256 + n * 64 + c4) = wv; }
}

constexpr int U_GEMM = 0, U_LRUA_LAT = 16, U_LRUA_CTX = 272, U_DIFF_LAT = 400, U_RET_LAT = 656, U_SWA_LAT = 912, U_RET_CTX = 1168, U_SWA_CTX = 1296, U_RST = 1424, U_LRUB_LAT = 1488, U_LRUB_CTX = 1744, U_DIFF_CTX = 1872, U_END = 2000;
__device__ __forceinline__ void mix_phase(const Args& a0, LAS unsigned char* lds, int layer_in, const int wave_s__, const int xcc) {
    volatile LAS int* sh = (volatile LAS int*)(lds + LDS_MISC);
    unsigned* ctr = (unsigned*)(a0.ws + WS_CTL) + 64 * (1 + layer_in);
    unsigned* dcnt = (unsigned*)(a0.ws + WS_CTL) + 64 * (9 + layer_in);
    unsigned* ctrq = (unsigned*)(a0.ws + WS_CTL) + 2048 + layer_in * 512;
    int qtry = 0; bool head_done = false;
#define MIX_CLAIM(dst) do { int u_ = U_END; \
        if (!head_done) { const int v_ = (int)atomicAdd(ctr, 1u); if (v_ < 16) u_ = v_; else head_done = true; } \
        while (u_ == U_END && qtry < 8) { const int q_ = (xcc + qtry) & 7; const int v_ = (int)atomicAdd(ctrq + 64 * q_, 1u); \
            if (v_ < 248) { \
                if (v_ < 32) u_ = U_LRUA_LAT + q_ * 32 + v_; else if (v_ < 48) u_ = U_LRUA_CTX + q_ * 16 + (v_ - 32); else if (v_ < 80) u_ = U_DIFF_LAT + q_ * 32 + (v_ - 48); \
                else if (v_ < 112) u_ = U_RET_LAT + q_ * 32 + (v_ - 80); else if (v_ < 144) u_ = U_SWA_LAT + q_ * 32 + (v_ - 112); else if (v_ < 160) u_ = U_RET_CTX + q_ * 16 + (v_ - 144); \
                else if (v_ < 176) u_ = U_SWA_CTX + q_ * 16 + (v_ - 160); else if (v_ < 184) u_ = U_RST + q_ * 8 + (v_ - 176); else if (v_ < 216) u_ = U_LRUB_LAT + q_ * 32 + (v_ - 184); \
                else if (v_ < 232) u_ = U_LRUB_CTX + q_ * 16 + (v_ - 216); else u_ = U_DIFF_CTX + q_ * 16 + (v_ - 232); \
            } else ++qtry; } \
        dst = u_; } while (0)
    int nxt = U_END;
    if (TIDX == 0) MIX_CLAIM(nxt);
    for (;;) {
        __syncthreads();
        if (TIDX == 0) sh[0] = nxt;
        __syncthreads();
        const int u = sh[0];
        if (u >= U_END) break;
        if (TIDX == 0) MIX_CLAIM(nxt);
        auto kp = __builtin_amdgcn_kernarg_segment_ptr(); asm volatile("" : "+s"(kp));
        const Args& a = *(const Args*)kp;
        int layer = layer_in; asm volatile("" : "+s"(layer));
        if (u < U_LRUA_LAT) {
            unsigned char* wsl = a.ws;
            pg8::Gemm gm{(const bf16*)(wsl + WS_XB), (const bf16*)(wsl + WS_WIN) + (size_t)layer * DIN * DM, NTOK, DIN, DM}; OneUnit S{u, 8};
            EpiIn E{(bf16*)(wsl + WS_Z), (const float*)(wsl + WS_SS), (const float*)(wsl + WS_B1) + (size_t)layer * NG * DIN, a.out, (const f32x4*)(wsl + WS_CS64), (const f32x4*)(wsl + WS_CS32), layer};
            pg8::gemm_phase<EpiIn, OneUnit, true, true>(lds, gm, S, E, wave_s__);
            asm volatile("s_waitcnt vmcnt(0)" ::: "memory"); __syncthreads();
            if (TIDX == 0) { __builtin_amdgcn_fence(__ATOMIC_RELEASE, "agent"); asm volatile("s_waitcnt vmcnt(0)" ::: "memory"); __hip_atomic_fetch_add((GAS unsigned*)dcnt, 1u, __ATOMIC_RELAXED, __HIP_MEMORY_SCOPE_AGENT); }
        }
        else if (u < U_LRUA_CTX) { const int r = u - U_LRUA_LAT; lru_a_unit(a, lds, layer, 16 + (r >> 5), (r >> 3) & 3, r & 7, wave_s__); }
        else if (u < U_DIFF_LAT) { const int r = u - U_LRUA_CTX; lru_a_unit(a, lds, layer, r >> 3, (r >> 1) & 3, r & 1, wave_s__); }
        else if (u < U_RET_LAT) { const int r = u - U_DIFF_LAT; attn_unit<2>(a, lds, layer, 16 + (r >> 5), (r >> 3) & 3, r & 7, wave_s__); }
        else if (u < U_SWA_LAT) { const int r = u - U_RET_LAT; attn_unit<0>(a, lds, layer, 16 + (r >> 5), (r >> 3) & 3, r & 7, wave_s__); }
        else if (u < U_RET_CTX) { const int r = u - U_SWA_LAT; attn_unit<1>(a, lds, layer, 16 + (r >> 5), (r >> 3) & 3, r & 7, wave_s__); }
        else if (u < U_SWA_CTX) { const int r = u - U_RET_CTX; attn_unit<0>(a, lds, layer, r >> 3, (r >> 1) & 3, r & 1, wave_s__); }
        else if (u < U_RST) { const int r = u - U_SWA_CTX; attn_unit<1>(a, lds, layer, r >> 3, (r >> 1) & 3, r & 1, wave_s__); }
        else if (u < U_LRUB_LAT) { const int r = u - U_RST; ret_state_unit(a, lds, layer, r >> 2, r & 3, wave_s__); }
        else if (u < U_LRUB_CTX) { const int r = u - U_LRUB_LAT; lru_b_unit(a, lds, layer, 16 + (r >> 5), (r >> 3) & 3, r & 7, wave_s__); }
        else if (u < U_DIFF_CTX) { const int r = u - U_LRUB_CTX; lru_b_unit(a, lds, layer, r >> 3, (r >> 1) & 3, r & 1, wave_s__); }
        else { const int r = u - U_DIFF_CTX;
            wait_count(dcnt, 16u, TIDX == 0);
            attn_unit<2>(a, lds, layer, r >> 3, (r >> 1) & 3, r & 1, wave_s__); }
    }
#undef MIX_CLAIM
}

__device__ __forceinline__ void prep_transposes(const Args& a, LAS unsigned char* lds, int l, int vb, int nb, const int wave_s__) {
    int tid_l = TIDX; asm volatile("" : "+v"(tid_l));
    const int lane = tid_l & 63, wave = tid_l >> 6;
    unsigned char* ws = a.ws;
    LAS float* scr = (LAS float*)(lds + wave * 16384);
    constexpr int IT_IN = (DM / 64) * (DIN / 32), IT_OUT = (DM / 64) * (DM / 32), IT_F1 = (DM / 64) * (DFF / 32), IT_F2 = (DFF / 64) * (DM / 32), IT_L = IT_IN + IT_OUT + IT_F1 + IT_F2;
    for (int it = vb * 8 + wave; it < IT_L; it += nb * 8) { int r = it;
        if (r < IT_IN) { transpose_item<true>(a.in[I_WIN] + (size_t)l * DM * DIN, DM, DIN, (bf16*)(ws + WS_WIN) + (size_t)l * DIN * DM, scr, r, lane); continue; } r -= IT_IN;
        if (r < IT_OUT) { transpose_item<false>(a.in[I_WOUT] + (size_t)l * DM * DM, DM, DM, (bf16*)(ws + WS_WOUT) + (size_t)l * DM * DM, scr, r, lane); continue; } r -= IT_OUT;
        if (r < IT_F1) { transpose_item<false>(a.in[I_WFF1] + (size_t)l * DM * DFF, DM, DFF, (bf16*)(ws + WS_WFF1) + (size_t)l * DFF * DM, scr, r, lane); continue; } r -= IT_F1;
        transpose_item<false>(a.in[I_WFF2] + (size_t)l * DFF * DM, DFF, DM, (bf16*)(ws + WS_WFF2) + (size_t)l * DM * DFF, scr, r, lane); }
}
__device__ __forceinline__ void prep_bias(const Args& a, LAS unsigned char* lds, int l, int vb, int nb, const int wave_s__) {
    unsigned char* ws = a.ws; const float* m = (const float*)(ws + WS_MOD) + (size_t)l * NG * NMOD;
    for (int r = vb; r < DIN / 64 + DFF / 64; r += nb) {
        if (r < DIN / 64) gemv_item<false, true>(lds, a.in[I_WIN] + (size_t)l * DM * DIN, DIN, r * 64, m, m + NMOD, NMOD, nullptr, (float*)(ws + WS_B1) + (size_t)l * NG * DIN, DIN, wave_s__);
        else gemv_item<false, false>(lds, a.in[I_WFF1] + (size_t)l * DM * DFF, DFF, (r - DIN / 64) * 64, m + 3072, m + NMOD + 3072, NMOD, nullptr, (float*)(ws + WS_B2) + (size_t)l * NG * DFF, DFF, wave_s__); }
}

#define XB_TMO      128
#define XB_XCNT(j)  (256  + 64 * (j))
#define XB_XSUB(j)  (1280 + 64 * (j))
#define XB_XGEN(j)  (2304 + 64 * (j))
#define XB_TOP      3328
#define XB_TOPGEN   3392
#define XCD_BAR_WORDS 3456
#define XB_SPIN_CAP (1u << 18)

__device__ __forceinline__ unsigned xb_ld(unsigned* p)              { return __hip_atomic_load(p, __ATOMIC_RELAXED, __HIP_MEMORY_SCOPE_AGENT); }
__device__ __forceinline__ unsigned xb_add(unsigned* p, unsigned v) { return __hip_atomic_fetch_add(p, v, __ATOMIC_RELAXED, __HIP_MEMORY_SCOPE_AGENT); }
__device__ __forceinline__ unsigned xb_xcc_id() { return (unsigned)__builtin_amdgcn_s_getreg((3 << 11) | 20) & 0xFu; }
#define XB_SPIN(cond, bar) do { unsigned _sp = 0; while (cond) { __builtin_amdgcn_s_sleep(1); \
    if ((++_sp & 255u) == 0u) { if (xb_ld(&(bar)[XB_TMO])) break; if (_sp > XB_SPIN_CAP) { atomicAdd(&(bar)[XB_TMO], 1u); break; } } } } while (0)

struct XcdBarrier {
    unsigned* bar; unsigned x;
    volatile LAS unsigned* st;
};

__device__ __forceinline__ XcdBarrier xcd_barrier_post(unsigned* bar, volatile LAS unsigned* st, const int wave_s__) {
    XcdBarrier b; b.bar = bar; b.x = xb_xcc_id(); b.st = st;
    if (TIDX == 0) (void)xb_add(&bar[XB_XCNT(b.x)], 1u);
    return b;
}
__device__ __forceinline__ void xcd_barrier_complete(unsigned* bar, unsigned x, unsigned& nloc, unsigned& nx) {
    const unsigned G = gridDim.x * gridDim.y * gridDim.z;
    unsigned sum, cnt, mine, sp = 0u;
    for (;;) {
        sum = 0u; cnt = 0u; mine = 0u;
#pragma unroll
        for (unsigned j = 0; j < 16; ++j) { const unsigned c = xb_ld(&bar[XB_XCNT(j)]); sum += c; cnt += (c > 0u) ? 1u : 0u; mine = (j == x) ? c : mine; }
        if (sum == G) break;
        __builtin_amdgcn_s_sleep(1);
        if ((++sp & 255u) == 0u) { if (xb_ld(&bar[XB_TMO])) break; if (sp > XB_SPIN_CAP) { atomicAdd(&bar[XB_TMO], 1u); break; } }
    }
    nloc = mine > 0u ? mine : 1u; nx = cnt > 0u ? cnt : 1u;
}

__device__ __forceinline__ void xcd_barrier(const XcdBarrier& b, const int wave_s__) {
    asm volatile("s_waitcnt vmcnt(0)" ::: "memory");
    __syncthreads();
    if (TIDX == 0) {
        unsigned* bar = b.bar;
        __builtin_amdgcn_s_waitcnt(0);
        unsigned nloc = b.st[0], nx = b.st[1];
        const unsigned old = xb_add(&bar[XB_XSUB(b.x)], 1u);
        const unsigned gen = old / nloc;
        if (old + 1u == (gen + 1u) * nloc) {
            __builtin_amdgcn_fence(__ATOMIC_RELEASE, "agent");
            asm volatile("s_waitcnt vmcnt(0)" ::: "memory");
            const unsigned og = xb_add(&bar[XB_TOP], 1u);
            const unsigned tg = og / nx;
            if (og + 1u == (tg + 1u) * nx) xb_add(&bar[XB_TOPGEN], 1u);
            else XB_SPIN(xb_ld(&bar[XB_TOPGEN]) == tg, bar);
            __builtin_amdgcn_fence(__ATOMIC_ACQUIRE, "agent");
            xb_add(&bar[XB_XGEN(b.x)], 1u);
            asm volatile("s_waitcnt vmcnt(0)" ::: "memory");
        } else {
            XB_SPIN(xb_ld(&bar[XB_XGEN(b.x)]) == gen, bar);
            __builtin_amdgcn_fence(__ATOMIC_ACQUIRE, "agent");
            asm volatile("s_waitcnt vmcnt(0)" ::: "memory");
        }
    }
    __syncthreads();
}

__global__ void __launch_bounds__(NT, 2) fwd_megakernel(Args a) {
    extern __shared__ __attribute__((aligned(16))) unsigned char lds_raw[];
    LAS unsigned char* lds = (LAS unsigned char*)lds_raw;
    cg::grid_group grid = cg::this_grid();
    const int wave_s__ = __builtin_amdgcn_readfirstlane((int)threadIdx.x >> 6);
    const int tid = TIDX, lane = tid & 63, wave = wave_s__, G = gridDim.x, bid = blockIdx.x;
    if (tid < 64) ((LAS unsigned*)(lds + LDS_MISC))[tid] = 0u;
    __syncthreads();
    const XcdBarrier bar = xcd_barrier_post((unsigned*)(a.ws + WS_CTL) + CW_BAR, (volatile LAS unsigned*)(lds + LDS_MISC) + 8, wave_s__);
#define GRID_BAR() do { XcdBarrier bb_ = bar; asm volatile("" : "+s"(bb_.x)); xcd_barrier(bb_, wave_s__); } while (0)
    const int gw = bid * 8 + wave, NGW = G * 8;
    {
    unsigned char* ws = a.ws;
    float* MOD = (float*)(ws + WS_MOD); float* GM = (float*)(ws + WS_GM); float* B1 = (float*)(ws + WS_B1); float* B2 = (float*)(ws + WS_B2);
    float* SS = (float*)(ws + WS_SS); float* X = (float*)(ws + WS_X); bf16* XB = (bf16*)(ws + WS_XB); bf16* Z = (bf16*)(ws + WS_Z); bf16* Y = (bf16*)(ws + WS_Y); bf16* H = (bf16*)(ws + WS_H);
    bf16* WIN = (bf16*)(ws + WS_WIN); bf16* WOUT = (bf16*)(ws + WS_WOUT); bf16* WFF1 = (bf16*)(ws + WS_WFF1); bf16* WFF2 = (bf16*)(ws + WS_WFF2);

    for (int it = bid; it < 4 * (NMOD / 64); it += G) { const int l = it / (NMOD / 64), n0 = (it % (NMOD / 64)) * 64;
        gemv_item<true, false>(lds, a.in[I_WADA] + (size_t)l * DM * NMOD, NMOD, n0, a.in[I_CCTX], a.in[I_C], DM, a.in[I_BADA] + (size_t)l * NMOD, MOD + (size_t)l * NG * NMOD, NMOD, wave_s__); }
    __syncthreads();
    prep_transposes(a, lds, 0, bid, G, wave_s__);
    for (int i = bid * NT + tid; i < 4 * 2 * 2 * 4 * 4096; i += G * NT) {
        const int c = i & 63, d = (i >> 6) & 63, nb = (i >> 12) & 3, gate = (i >> 14) & 1, ld = i >> 15;
        ((bf16*)(ws + WS_WLRU))[i] = (bf16)f2bf(a.in[gate ? I_LWX : I_LWA][((size_t)(ld * 4 + nb) * 64 + c) * 64 + d]); }
    for (int i = bid * NT + tid; i < 1024 * 32 + 1024 * 16; i += G * NT) {
        if (i < 1024 * 32) { const int pos = i >> 5, k = i & 31; const float inv = exp2f(-(float)(k & 15) * (13.287712379549449f / 16.f)); const float ang = (float)(k < 16 ? (pos >> 6) : (pos & 63)) * inv;
            ((f32x2*)(ws + WS_CS64))[i] = (f32x2){cosf(ang), sinf(ang)}; }
        else { const int j = i - 1024 * 32, pos = j >> 4, k = j & 15; const float inv = exp2f(-(float)(k & 7) * (13.287712379549449f / 8.f)); const float ang = (float)(k < 8 ? (pos >> 6) : (pos & 63)) * inv;
            ((f32x2*)(ws + WS_CS32))[j] = (f32x2){cosf(ang), sinf(ang)}; }
    }
    if (a.ws == nullptr) grid.sync();
    if (tid == 0) { unsigned nloc, nx; xcd_barrier_complete(bar.bar, bar.x, nloc, nx); bar.st[0] = nloc; bar.st[1] = nx; }
    __syncthreads();
    GRID_BAR();
    prep_bias(a, lds, 0, bid, G, wave_s__);
    for (int i = bid * NT + tid; i < 4 * 2 * NG * DM; i += G * NT) { const int k = i & 1023, g = (i >> 10) % NG, which = (i / (NG * DM)) & 1, l = i / (2 * NG * DM);
        GM[i] = a.in[which ? I_NMLPG : I_NMIXG][l * DM + k] * (1.f + MOD[((size_t)l * NG + g) * NMOD + (which ? 4096 : 1024) + k]); }
    for (int rowa = gw; rowa < NTOK; rowa += 2 * NGW) {
        f32x4 xv[2][4], ngv[4], scv[2][4]; bool ok[2];
#pragma unroll
        for (int j = 0; j < 4; ++j) ngv[j] = *(const f32x4*)(a.in[I_NMIXG] + 4 * lane + 256 * j);
#pragma unroll
        for (int q = 0; q < 2; ++q) { const int row = rowa + q * NGW; ok[q] = row < NTOK;
            if (ok[q]) { const float* xr = row < NCTX ? a.in[I_XP] + (size_t)row * DM : a.in[I_XS] + (size_t)(row - NCTX) * DM; const int g = grp_of_row(row);
#pragma unroll
                for (int j = 0; j < 4; ++j) { const int c = 4 * lane + 256 * j; xv[q][j] = *(const f32x4*)(xr + c); scv[q][j] = *(const f32x4*)(MOD + (size_t)g * NMOD + 1024 + c); } } }
#pragma unroll
        for (int q = 0; q < 2; ++q) if (ok[q]) { const int row = rowa + q * NGW;
            float s = 0.f;
#pragma unroll
            for (int j = 0; j < 4; ++j) { const int c = 4 * lane + 256 * j; const f32x4 v = xv[q][j], ng = ngv[j], sc = scv[q][j]; s += (v[0] * v[0] + v[1] * v[1]) + (v[2] * v[2] + v[3] * v[3]);
                { u32x2 xw; xw.x = pk2(v[0], v[1]); xw.y = pk2(v[2], v[3]); *(u32x2*)((bf16*)X + (size_t)row * DM + c) = xw; }
                u32x2 wv; wv.x = pk2(v[0] * ng[0] * (1.f + sc[0]), v[1] * ng[1] * (1.f + sc[1])); wv.y = pk2(v[2] * ng[2] * (1.f + sc[2]), v[3] * ng[3] * (1.f + sc[3]));
                *(u32x2*)(XB + (size_t)row * DM + c) = wv; }
            s = wave_sum(s);
            if (lane < 16) SS[(size_t)row * 16 + lane] = lane == 0 ? s : 0.f; }
    }
    }
    GRID_BAR();
#define FRESH_WS() unsigned char* wsl = a.ws; asm volatile("" : "+s"(wsl))
#pragma unroll 1
    for (int l = 0; l < 4; ++l) {
        {   FRESH_WS();
            pg8::Gemm gm{(const bf16*)(wsl + WS_XB), (const bf16*)(wsl + WS_WIN) + (size_t)l * DIN * DM, NTOK, DIN, DM}; InOrder S{G, bid};
            EpiIn E{(bf16*)(wsl + WS_Z), (const float*)(wsl + WS_SS), (const float*)(wsl + WS_B1) + (size_t)l * NG * DIN, a.out, (const f32x4*)(wsl + WS_CS64), (const f32x4*)(wsl + WS_CS32), l};
            pg8::gemm_phase<EpiIn, InOrder, true, true>(lds, gm, S, E, wave_s__); }
        GRID_BAR();
        mix_phase(a, lds, l, wave_s__, (int)bar.x);
        GRID_BAR();
        {   FRESH_WS();
            pg8::Gemm gm{(const bf16*)(wsl + WS_Y), (const bf16*)(wsl + WS_WOUT) + (size_t)l * DM * DM, NTOK, DM, DM}; pg8::StaticOrder S; S.init(NTOK, DM, G, bid);
            EpiRes E{(bf16*)(wsl + WS_X), (bf16*)(wsl + WS_XB), (float*)(wsl + WS_SS), (const float*)(wsl + WS_MOD) + (size_t)l * NG * NMOD + 2048, (const float*)(wsl + WS_GM) + (size_t)(l * 2 + 1) * NG * DM};
            pg8::gemm_phase<EpiRes, pg8::StaticOrder, true, true>(lds, gm, S, E, wave_s__); }
        if (l < 3) { const int nb = G > 192 ? G - 192 : G, vb = G > 192 ? bid - 192 : bid; if (vb >= 0) prep_bias(a, lds, l + 1, vb, nb, wave_s__); }
        GRID_BAR();
        {   FRESH_WS();
            pg8::Gemm gm{(const bf16*)(wsl + WS_XB), (const bf16*)(wsl + WS_WFF1) + (size_t)l * DFF * DM, NTOK, DFF, DM}; pg8::StaticOrder S; S.init(NTOK, DFF, G, bid);
            EpiFF1 E{(bf16*)(wsl + WS_H), (const float*)(wsl + WS_SS), (const float*)(wsl + WS_B2) + (size_t)l * NG * DFF};
            pg8::gemm_phase<EpiFF1, pg8::StaticOrder, true, true>(lds, gm, S, E, wave_s__); }
        GRID_BAR();
        {   FRESH_WS();
            pg8::Gemm gm{(const bf16*)(wsl + WS_H), (const bf16*)(wsl + WS_WFF2) + (size_t)l * DM * DFF, NTOK, DM, DFF}; pg8::StaticOrder S; S.init(NTOK, DM, G, bid);
            EpiRes E{(bf16*)(wsl + WS_X), (bf16*)(wsl + WS_XB), (float*)(wsl + WS_SS), (const float*)(wsl + WS_MOD) + (size_t)l * NG * NMOD + 5120, l < 3 ? (const float*)(wsl + WS_GM) + (size_t)((l + 1) * 2 + 0) * NG * DM : nullptr};
            pg8::gemm_phase<EpiRes, pg8::StaticOrder, true, true>(lds, gm, S, E, wave_s__); }
        if (l < 3) { const int nb = G > 192 ? G - 192 : G, vb = G > 192 ? bid - 192 : bid; if (vb >= 0) prep_transposes(a, lds, l + 1, vb, nb, wave_s__); }
        GRID_BAR();
    }
    FRESH_WS();
    int tid_f = TIDX; asm volatile("" : "+v"(tid_f));
    const int lane_f = tid_f & 63, gw_f = bid * 8 + (tid_f >> 6);
    for (int row = gw_f; row < NTOK; row += NGW) {
        const f32x4 sa = *(const f32x4*)((const float*)(wsl + WS_SS) + (size_t)row * 16 + 4 * (lane_f & 3));
        u32x2 xw[4]; f32x4 fgv[4];
#pragma unroll
        for (int j = 0; j < 4; ++j) { const int c = 4 * lane_f + 256 * j; xw[j] = *(const u32x2*)((const bf16*)(wsl + WS_X) + (size_t)row * DM + c); fgv[j] = *(const f32x4*)(a.in[I_FNG] + c); }
        float ps = (sa[0] + sa[1]) + (sa[2] + sa[3]);
        ps += asf_(__builtin_amdgcn_update_dpp(0, asu_(ps), 0xB1, 0xF, 0xF, true)); ps += asf_(__builtin_amdgcn_update_dpp(0, asu_(ps), 0x4E, 0xF, 0xF, true));
        const float rs = rsqrtf(ps * (1.f / DM) + EPS);
#pragma unroll
        for (int j = 0; j < 4; ++j) { const int c = 4 * lane_f + 256 * j; const f32x4 v = {bflo(xw[j].x), bfhi(xw[j].x), bflo(xw[j].y), bfhi(xw[j].y)};
            *(f32x4*)(a.out + (size_t)row * DM + c) = v * rs * fgv[j]; }
    }
}

extern "C" void kernel_launch(void* const* d_in, const int* in_sizes, int n_in, void* d_out, int out_size, void* d_ws, size_t ws_size, hipStream_t stream) {
    static int grid = 0;
    if (grid == 0) {
        if (n_in != N_IN || ws_size < WS_END) { fprintf(stderr, "kernel_launch: expected %d inputs and >= %zu bytes of workspace, got %d / %zu\n", (int)N_IN, (size_t)WS_END, n_in, ws_size); grid = -1; return; }
        int dev = 0, cus = 0, per_cu = 0;
        (void)hipGetDevice(&dev); (void)hipDeviceGetAttribute(&cus, hipDeviceAttributeMultiprocessorCount, dev);
        if (hipFuncSetAttribute((const void*)fwd_megakernel, hipFuncAttributeMaxDynamicSharedMemorySize, LDS_BYTES) != hipSuccess) { fprintf(stderr, "kernel_launch: hipFuncSetAttribute failed\n"); grid = -1; return; }
        if (hipOccupancyMaxActiveBlocksPerMultiprocessor(&per_cu, (const void*)fwd_megakernel, NT, LDS_BYTES) != hipSuccess || per_cu < 1) { fprintf(stderr, "kernel_launch: occupancy query gave %d\n", per_cu); per_cu = 1; }
        (void)hipGetLastError();
        grid = cus * 1;
        fprintf(stderr, "kernel_launch: grid %d (cus %d, per_cu %d)\n", grid, cus, per_cu);
    }
    if (grid < 0) return;
    (void)hipMemsetAsync((char*)d_ws + WS_CTL, 0, 32768, stream);
    Args a{};
    for (int i = 0; i < N_IN; ++i) a.in[i] = (const float*)d_in[i];
    a.out = (float*)d_out; a.ws = (unsigned char*)d_ws;
    void* args[] = {&a};
    hipError_t e = hipLaunchCooperativeKernel((const void*)fwd_megakernel, dim3(grid), dim3(NT), args, LDS_BYTES, stream);
    if (e != hipSuccess) fprintf(stderr, "kernel_launch: cooperative launch failed: %s (grid %d)\n", hipGetErrorString(e), grid);
}
```
